# Optimizing an MI355X kernel written in HIP

```python
import math
import jax, jax.numpy as jnp
from jax import lax
import numpy as np

D_MODEL = 1024
BATCH = 8
SEQ = 4096
DEPTH = 1

CHUNK = 64
Q_BLOCK = 128
ATTN_HEADS = 4
ATTN_QK_DIM = 64
ATTN_V_DIM = 2 * ATTN_QK_DIM
ATTN_WIDTH = ATTN_HEADS * ATTN_V_DIM
ATTN_QK_WIDTH = ATTN_HEADS * 2 * ATTN_QK_DIM
SSM_GROUP = 16
SSM_STATE = 64
SSM_WIDTH = D_MODEL // 2
SSM_GROUPS = SSM_WIDTH // SSM_GROUP
N_BRANCH = 2
D_FF = 4 * D_MODEL
IN_COLS = 2 * ATTN_QK_WIDTH + ATTN_WIDTH + SSM_WIDTH + N_BRANCH * D_MODEL
EPS = 1e-6
DT_MIN = 1e-3
DT_MAX = 1e-1

kernel_name = "gated_diffattn_s5_hybrid_block"


def rms_norm(x, g):
    xf = x.astype(jnp.float32)
    y = xf * lax.rsqrt(jnp.mean(xf * xf, axis=-1, keepdims=True) + EPS)
    return (y * g.astype(jnp.float32)).astype(x.dtype)


def lambda_init_fn(layer_idx):
    return 0.8 - 0.6 * math.exp(-0.3 * layer_idx)


def diff_attention(q, k, v, q_norm_g, k_norm_g, lambda_q1, lambda_k1, lambda_q2, lambda_k2,
                   subln_g, layer_idx):
    bsz, seq, _ = q.shape
    dtype = q.dtype
    q = rms_norm(q.reshape(bsz, seq, ATTN_HEADS, 2, ATTN_QK_DIM), q_norm_g)
    k = rms_norm(k.reshape(bsz, seq, ATTN_HEADS, 2, ATTN_QK_DIM), k_norm_g)
    q1 = jnp.transpose(q[:, :, :, 0], (0, 2, 1, 3))
    q2 = jnp.transpose(q[:, :, :, 1], (0, 2, 1, 3))
    k1 = jnp.transpose(k[:, :, :, 0], (0, 2, 1, 3))
    k2 = jnp.transpose(k[:, :, :, 1], (0, 2, 1, 3))
    vh = jnp.transpose(v.reshape(bsz, seq, ATTN_HEADS, ATTN_V_DIM), (0, 2, 1, 3))

    lam_init = lambda_init_fn(layer_idx)
    lam = (jnp.exp(jnp.sum(lambda_q1.astype(jnp.float32) * lambda_k1.astype(jnp.float32)))
           - jnp.exp(jnp.sum(lambda_q2.astype(jnp.float32) * lambda_k2.astype(jnp.float32)))
           + lam_init)
    scale = ATTN_QK_DIM ** -0.5
    k_chunk = jnp.arange(seq) // CHUNK
    n_blocks = seq // Q_BLOCK

    def one_block(i):
        start = i * Q_BLOCK
        q1b = lax.dynamic_slice_in_dim(q1, start, Q_BLOCK, axis=2)
        q2b = lax.dynamic_slice_in_dim(q2, start, Q_BLOCK, axis=2)
        q_chunk = (start + jnp.arange(Q_BLOCK)) // CHUNK
        allowed = k_chunk[None, :] <= q_chunk[:, None]
        s1 = jnp.einsum('bhqd,bhkd->bhqk', q1b, k1).astype(jnp.float32) * scale
        s2 = jnp.einsum('bhqd,bhkd->bhqk', q2b, k2).astype(jnp.float32) * scale
        p1 = jax.nn.softmax(jnp.where(allowed, s1, -jnp.inf), axis=-1)
        p2 = jax.nn.softmax(jnp.where(allowed, s2, -jnp.inf), axis=-1)
        w = (p1 - lam * p2).astype(dtype)
        return jnp.einsum('bhqk,bhkd->bhqd', w, vh)

    o = lax.map(one_block, jnp.arange(n_blocks))
    o = jnp.transpose(o, (1, 0, 3, 2, 4)).reshape(bsz, seq, ATTN_HEADS, ATTN_V_DIM)
    o = rms_norm(o, subln_g) * (1.0 - lam_init)
    return o.reshape(bsz, seq, ATTN_WIDTH).astype(dtype)


def _complex_affine_combine(e1, e2):
    a1r, a1i, b1r, b1i = e1
    a2r, a2i, b2r, b2i = e2
    ar = a1r * a2r - a1i * a2i
    ai = a1r * a2i + a1i * a2r
    br = a2r * b1r - a2i * b1i + b2r
    bi = a2r * b1i + a2i * b1r + b2i
    return (ar, ai, br, bi)


def s5_branch(u, a_re, a_im, log_dt, b_re, b_im, c_re, c_im, d, w_glu, b_glu):
    dtype = u.dtype
    bsz, seq, _ = u.shape
    uf = u.astype(jnp.float32)
    ug = uf.reshape(bsz, seq, SSM_GROUPS, SSM_GROUP)
    ar = a_re.astype(jnp.float32)
    ai = a_im.astype(jnp.float32)
    dt = jnp.exp(log_dt.astype(jnp.float32))[:, None]
    mag = jnp.exp(ar * dt)
    ang = ai * dt
    lb_re = mag * jnp.cos(ang)
    lb_im = mag * jnp.sin(ang)
    den = ar * ar + ai * ai
    nr = lb_re - 1.0
    ni = lb_im
    f_re = (nr * ar + ni * ai) / den
    f_im = (ni * ar - nr * ai) / den
    br = b_re.astype(jnp.float32)
    bi = b_im.astype(jnp.float32)
    bb_re = f_re[..., None] * br - f_im[..., None] * bi
    bb_im = f_re[..., None] * bi + f_im[..., None] * br
    bu_re = jnp.einsum('blgn,gpn->blgp', ug, bb_re)
    bu_im = jnp.einsum('blgn,gpn->blgp', ug, bb_im)
    a_r = jnp.broadcast_to(lb_re, (1, seq, SSM_GROUPS, SSM_STATE))
    a_i = jnp.broadcast_to(lb_im, (1, seq, SSM_GROUPS, SSM_STATE))
    _, _, xr, xi = lax.associative_scan(_complex_affine_combine, (a_r, a_i, bu_re, bu_im), axis=1)
    y = (jnp.einsum('blgp,gnp->blgn', xr, c_re.astype(jnp.float32))
         - jnp.einsum('blgp,gnp->blgn', xi, c_im.astype(jnp.float32)))
    y = y.reshape(bsz, seq, SSM_WIDTH) + d.astype(jnp.float32) * uf
    z = jax.nn.gelu(y).astype(dtype)
    return z * jax.nn.sigmoid(z @ w_glu + b_glu)


def hybrid_layer(x, layer_idx, norm_mix_g, w_in, b_gate, q_norm_g, k_norm_g,
                 lambda_q1, lambda_k1, lambda_q2, lambda_k2, subln_g,
                 ssm_a_re, ssm_a_im, ssm_log_dt, ssm_b_re, ssm_b_im, ssm_c_re, ssm_c_im,
                 ssm_d, w_glu, b_glu, w_proj_attn, w_proj_ssm, w_out,
                 norm_mlp_g, w_mlp_in, w_mlp_out):
    h = rms_norm(x, norm_mix_g)
    proj = h @ w_in
    o1 = ATTN_QK_WIDTH
    o2 = o1 + ATTN_QK_WIDTH
    o3 = o2 + ATTN_WIDTH
    o4 = o3 + SSM_WIDTH
    q, k, v, u, g = proj[..., :o1], proj[..., o1:o2], proj[..., o2:o3], proj[..., o3:o4], proj[..., o4:]
    gates = jax.nn.sigmoid(g + b_gate)
    g_attn, g_ssm = gates[..., :D_MODEL], gates[..., D_MODEL:]

    a = diff_attention(q, k, v, q_norm_g, k_norm_g, lambda_q1, lambda_k1, lambda_q2, lambda_k2,
                       subln_g, layer_idx)
    s = s5_branch(u, ssm_a_re, ssm_a_im, ssm_log_dt, ssm_b_re, ssm_b_im, ssm_c_re, ssm_c_im,
                  ssm_d, w_glu, b_glu)
    merged = g_attn * (a @ w_proj_attn) + g_ssm * (s @ w_proj_ssm)
    x = x + merged @ w_out

    hm = rms_norm(x, norm_mlp_g)
    x = x + jnp.square(jax.nn.relu(hm @ w_mlp_in)) @ w_mlp_out
    return x


def setup_inputs(seed: int = 0) -> dict:
    key = jax.random.key(seed)
    ks = jax.random.split(key, 32)
    L = DEPTH
    f32 = jnp.float32

    def nrm(k, shape, scale):
        return jax.random.normal(k, shape, f32) * scale

    x = jax.random.normal(ks[0], (BATCH, SEQ, D_MODEL), f32)
    a_re = -0.5 + 0.01 * jax.random.normal(ks[1], (L, SSM_GROUPS, SSM_STATE), f32)
    a_im = (jnp.pi * jnp.arange(SSM_STATE, dtype=f32))[None, None, :] \
        + 0.01 * jax.random.normal(ks[2], (L, SSM_GROUPS, SSM_STATE), f32)
    log_dt = jax.random.uniform(ks[3], (L, SSM_GROUPS), f32, math.log(DT_MIN), math.log(DT_MAX))
    return {
        "x": x,
        "norm_mix_g": 1.0 + nrm(ks[4], (L, D_MODEL), 0.02),
        "w_in": nrm(ks[5], (L, D_MODEL, IN_COLS), D_MODEL ** -0.5),
        "b_gate": nrm(ks[6], (L, N_BRANCH * D_MODEL), 0.02),
        "q_norm_g": 1.0 + nrm(ks[7], (L, ATTN_QK_DIM), 0.02),
        "k_norm_g": 1.0 + nrm(ks[8], (L, ATTN_QK_DIM), 0.02),
        "lambda_q1": nrm(ks[9], (L, ATTN_QK_DIM), 0.1),
        "lambda_k1": nrm(ks[10], (L, ATTN_QK_DIM), 0.1),
        "lambda_q2": nrm(ks[11], (L, ATTN_QK_DIM), 0.1),
        "lambda_k2": nrm(ks[12], (L, ATTN_QK_DIM), 0.1),
        "subln_g": 1.0 + nrm(ks[13], (L, ATTN_V_DIM), 0.02),
        "ssm_a_re": a_re,
        "ssm_a_im": a_im,
        "ssm_log_dt": log_dt,
        "ssm_b_re": nrm(ks[14], (L, SSM_GROUPS, SSM_STATE, SSM_GROUP), (0.5 / SSM_GROUP) ** 0.5),
        "ssm_b_im": nrm(ks[15], (L, SSM_GROUPS, SSM_STATE, SSM_GROUP), (0.5 / SSM_GROUP) ** 0.5),
        "ssm_c_re": nrm(ks[16], (L, SSM_GROUPS, SSM_GROUP, SSM_STATE), (0.5 / SSM_STATE) ** 0.5),
        "ssm_c_im": nrm(ks[17], (L, SSM_GROUPS, SSM_GROUP, SSM_STATE), (0.5 / SSM_STATE) ** 0.5),
        "ssm_d": nrm(ks[18], (L, SSM_WIDTH), 1.0),
        "w_glu": nrm(ks[19], (L, SSM_WIDTH, SSM_WIDTH), SSM_WIDTH ** -0.5),
        "b_glu": nrm(ks[20], (L, SSM_WIDTH), 0.02),
        "w_proj_attn": nrm(ks[21], (L, ATTN_WIDTH, D_MODEL), ATTN_WIDTH ** -0.5),
        "w_proj_ssm": nrm(ks[22], (L, SSM_WIDTH, D_MODEL), SSM_WIDTH ** -0.5),
        "w_out": nrm(ks[23], (L, D_MODEL, D_MODEL), D_MODEL ** -0.5),
        "norm_mlp_g": 1.0 + nrm(ks[24], (L, D_MODEL), 0.02),
        "w_mlp_in": nrm(ks[25], (L, D_MODEL, D_FF), D_MODEL ** -0.5),
        "w_mlp_out": nrm(ks[26], (L, D_FF, D_MODEL), D_FF ** -0.5),
    }


def reference(x, norm_mix_g, w_in, b_gate, q_norm_g, k_norm_g, lambda_q1, lambda_k1,
              lambda_q2, lambda_k2, subln_g, ssm_a_re, ssm_a_im, ssm_log_dt, ssm_b_re,
              ssm_b_im, ssm_c_re, ssm_c_im, ssm_d, w_glu, b_glu, w_proj_attn, w_proj_ssm,
              w_out, norm_mlp_g, w_mlp_in, w_mlp_out):
    for l in range(DEPTH):
        x = hybrid_layer(
            x, l, norm_mix_g[l], w_in[l], b_gate[l], q_norm_g[l], k_norm_g[l],
            lambda_q1[l], lambda_k1[l], lambda_q2[l], lambda_k2[l], subln_g[l],
            ssm_a_re[l], ssm_a_im[l], ssm_log_dt[l], ssm_b_re[l], ssm_b_im[l],
            ssm_c_re[l], ssm_c_im[l], ssm_d[l], w_glu[l], b_glu[l],
            w_proj_attn[l], w_proj_ssm[l], w_out[l],
            norm_mlp_g[l], w_mlp_in[l], w_mlp_out[l])
    return x
```

```cpp
#include <hip/hip_runtime.h>
#include <hip/hip_cooperative_groups.h>
#include <cstdio>
#include <cstdint>
namespace cg = cooperative_groups;

#define LAS __attribute__((address_space(3)))
typedef unsigned short bf16_t;
typedef short bf16x8 __attribute__((ext_vector_type(8)));
typedef short s16x4 __attribute__((ext_vector_type(4)));
typedef float f32x4 __attribute__((ext_vector_type(4)));
typedef float f32x16 __attribute__((ext_vector_type(16)));
typedef unsigned u32x4 __attribute__((ext_vector_type(4)));
typedef unsigned u32x2 __attribute__((ext_vector_type(2)));
typedef float f32x2_t __attribute__((ext_vector_type(2)));
typedef __bf16 bf16x2_t __attribute__((ext_vector_type(2)));

__device__ __forceinline__ unsigned pk2(float lo, float hi) { f32x2_t v = {lo, hi}; bf16x2_t b = __builtin_convertvector(v, bf16x2_t); return __builtin_bit_cast(unsigned, b); }
__device__ __forceinline__ float bf_lo(unsigned w) { return __uint_as_float(w << 16); }
__device__ __forceinline__ float bf_hi(unsigned w) { return __uint_as_float(w & 0xffff0000u); }
__device__ __forceinline__ float fast_sigmoid(float x) { return __builtin_amdgcn_rcpf(1.0f + __builtin_amdgcn_exp2f(-1.4426950408889634f * x)); }
__device__ __forceinline__ float wave_sum(float v) {
#pragma unroll
    for (int o = 1; o < 64; o <<= 1) v += __shfl_xor(v, o);
    return v;
}
__device__ __forceinline__ float wave_max(float v) {
#pragma unroll
    for (int o = 1; o < 64; o <<= 1) v = fmaxf(v, __shfl_xor(v, o));
    return v;
}

constexpr int BATCH = 8, SEQ = 4096, DM = 1024, TOK = BATCH * SEQ, FF = 4096, INC = 4096;
constexpr int NG = 32, NP = 64, NCH = 64;
constexpr float EPS = 1e-6f;
constexpr float C2 = 0.125f * 1.4426950408889634f;

constexpr size_t MiB = 1u << 20;
constexpr size_t WS_SMALL = 1 * MiB;
constexpr size_t OFF_LBR = 0, OFF_LBI = 8192, OFF_A64R = 16384, OFF_A64I = 24576;
constexpr size_t OFF_BBF = 32768;
constexpr size_t OFF_CF = 32768 + 131072;
constexpr size_t OFF_RSTD1 = 32768 + 262144;
constexpr size_t OFF_RSS2 = OFF_RSTD1 + 131072;
constexpr size_t WS_W_IN = 2 * MiB, WS_W_MI = 10 * MiB, WS_W_MO = 18 * MiB, WS_W_OUT = 26 * MiB, WS_W_PA = 28 * MiB, WS_W_PS = 29 * MiB, WS_W_GLU = 30 * MiB;
constexpr size_t WS_SEND = 32 * MiB, WS_CARRY = 40 * MiB;
constexpr size_t WS_Q = 64 * MiB, WS_K = 96 * MiB, WS_V = 128 * MiB, WS_U = 160 * MiB, WS_G = 192 * MiB, WS_XB = 320 * MiB;
constexpr size_t WS_MG = 128 * MiB;
constexpr size_t WS_H = 128 * MiB;
constexpr size_t WS_X1B = WS_Q;
constexpr size_t WS_AO = 384 * MiB;
constexpr size_t WS_END = 448 * MiB;

#ifndef PHMASK
#define PHMASK 0xFFFF
#endif
constexpr int LDS_BYTES = 147456;
constexpr int RING_BYTES = 131072;

namespace pg8 {
constexpr int BM = 256, BK = 64, HALF = 128, HTB = HALF * BK * 2, NXCD = 8, WGM = 8;
__host__ __device__ __forceinline__ int lds_byte(int r, int c) { const int st = (r >> 4) * 2 + (c >> 5), rr = r & 15, cc = c & 31, ob = rr * 64 + cc * 2; return st * 1024 + (ob ^ (((ob >> 9) & 1) << 5)); }
__host__ __device__ __forceinline__ void stage_rc(int b, int& R, int& C) { const int st = b / 1024, sb = b % 1024, swz = sb ^ (((sb >> 9) & 1) << 5); R = (st >> 1) * 16 + swz / 64; C = (st & 1) * 32 + (swz % 64) / 2; }
__host__ __device__ __forceinline__ int perm32(int rho) { const int n = rho >> 4, i = rho & 15; return 8 * (i >> 2) + 4 * n + (i & 3); }
__device__ __forceinline__ void pg8_glds16(const void* sbase, unsigned voff, unsigned lds_dst) { unsigned keep;
    asm volatile("s_mov_b32 %0, m0\n\ts_mov_b32 m0, %3\n\ts_nop 0\n\tglobal_load_lds_dwordx4 %1, %2\n\ts_mov_b32 m0, %0" : "=&s"(keep) : "v"(voff), "s"(sbase), "s"(lds_dst) : "memory"); }
struct Unit { int pm, pn; };
struct Gemm { const bf16_t* A; const bf16_t* Bt; int M, N, K; };
struct StaticOrder {
    int nM, nN, nwg, G, c;
    __device__ void init(int M, int N, int G_, int c_) { nM = M / BM; nN = N / BM; nwg = nM * nN; G = G_; c = c_; }
    __device__ bool next(int i, Unit& u) const {
        const long L = (long)i * G + c; if (L >= nwg) return false;
        int wgid = (int)L; { const int q = nwg / NXCD, r = nwg % NXCD, xcd = wgid % NXCD, off = wgid / NXCD; wgid = (xcd < r ? xcd * (q + 1) : r * (q + 1) + (xcd - r) * q) + off; }
        const int nig = WGM * nN, gid = wgid / nig, fm = gid * WGM, gsz = (nM - fm) < WGM ? (nM - fm) : WGM;
        u.pm = fm + ((wgid % nig) % gsz); u.pn = (wgid % nig) / gsz; return true;
    }
};

template <class Epi, class Sched, bool MID = false>
__device__ __forceinline__ void gemm_phase(LAS unsigned char* lds, const Gemm g, const Sched& S, const Epi& E) {
    int tid = threadIdx.x; asm volatile("" : "+v"(tid));
    const int wid = __builtin_amdgcn_readfirstlane(tid >> 6), lane = tid & 63, wr = wid >> 2, wc = wid & 3, fr = lane & 15, fq = lane >> 4;
    const int K = g.K, nt = K / BK;
    unsigned voffA[2], voffB[2];
#pragma unroll
    for (int i = 0; i < 2; ++i) { int R, C; stage_rc(tid * 16 + i * 8192, R, C); const int Rb = (R & ~31) + perm32(R & 31);
        voffA[i] = (unsigned)(R * K + C) * 2u; voffB[i] = (unsigned)(Rb * K + C) * 2u; }
    const size_t kstep = (size_t)(BK * 2);
    const size_t hstep = (size_t)HALF * K * 2;
    const size_t tstep = 2 * hstep;
    const unsigned ldsw = (unsigned)wid * 1024u; const unsigned lds0_ = (unsigned)(uintptr_t)lds;
    const int aoff = lds_byte(wr * 64 + fr, fq * 8), boff = lds_byte(wc * 32 + fr, fq * 8);
#define PG8_SA(b, h) (((b) * 2 + (h)) * HTB)
#define PG8_SB(b, h) ((4 + (b) * 2 + (h)) * HTB)
#define PG8_STAGE(bufoff, gbase, voff) do { _Pragma("unroll") for (int _i = 0; _i < 2; ++_i) \
        pg8_glds16((const void*)(gbase), (voff)[_i], (unsigned)__builtin_amdgcn_readfirstlane(lds0_ + (bufoff) + ldsw + _i * 8192)); } while (0)
#define PG8_LDA(dst, b, h) do { _Pragma("unroll") for (int m = 0; m < 4; ++m) _Pragma("unroll") for (int k = 0; k < 2; ++k) dst[m][k] = *(const LAS bf16x8*)(lds + PG8_SA(b, h) + aoff + m * 2048 + k * 1024); } while (0)
#define PG8_LDB(dst, b, h) do { _Pragma("unroll") for (int n = 0; n < 2; ++n) _Pragma("unroll") for (int k = 0; k < 2; ++k) dst[n][k] = *(const LAS bf16x8*)(lds + PG8_SB(b, h) + boff + n * 2048 + k * 1024); } while (0)
#define PG8_MMA(ai, bj, At, Bt) do { __builtin_amdgcn_s_setprio(1); _Pragma("unroll") for (int m = 0; m < 4; ++m) _Pragma("unroll") for (int n = 0; n < 2; ++n) _Pragma("unroll") for (int k = 0; k < 2; ++k) \
        acc[ai][bj][m][n] = __builtin_amdgcn_mfma_f32_16x16x32_bf16(Bt[n][k], At[m][k], acc[ai][bj][m][n], 0, 0, 0); __builtin_amdgcn_s_setprio(0); } while (0)
#define PG8_WAIT_V(n) asm volatile("s_waitcnt vmcnt(" #n ")" ::: "memory")
#define PG8_WAIT_L(n) asm volatile("s_waitcnt lgkmcnt(" #n ")" ::: "memory")
#define PG8_BAR __builtin_amdgcn_s_barrier()
#define PG8_SCHED __builtin_amdgcn_sched_barrier(0)
    Unit cur, nxt; int ui = 0;
    if (!S.next(0, cur)) return;
    f32x4 acc[2][2][4][2];
#pragma unroll
    for (int a = 0; a < 2; ++a)
#pragma unroll
        for (int b = 0; b < 2; ++b)
#pragma unroll
            for (int m = 0; m < 4; ++m)
#pragma unroll
                for (int n = 0; n < 2; ++n) acc[a][b][m][n] = (f32x4){0.f, 0.f, 0.f, 0.f};
    bf16x8 At[4][2], B0[2][2], B1[2][2];
    const char* cA = (const char*)g.A + (size_t)cur.pm * tstep; const char* cB = (const char*)g.Bt + (size_t)cur.pn * tstep;
    PG8_STAGE(PG8_SB(0, 0), cB, voffB); PG8_STAGE(PG8_SB(0, 1), cB + hstep, voffB); PG8_STAGE(PG8_SA(0, 0), cA, voffA); PG8_STAGE(PG8_SA(0, 1), cA + hstep, voffA);
    if (wr == 1) PG8_BAR;
    PG8_WAIT_V(2); PG8_BAR;
    PG8_STAGE(PG8_SB(1, 0), cB + kstep, voffB); PG8_STAGE(PG8_SA(1, 0), cA + kstep, voffA); PG8_STAGE(PG8_SB(1, 1), cB + hstep + kstep, voffB);
    PG8_WAIT_V(6); PG8_BAR;
    for (;;) {
        const bool has_next = S.next(ui + 1, nxt);
        const char* nA = has_next ? (const char*)g.A + (size_t)nxt.pm * tstep : cA; const char* nB = has_next ? (const char*)g.Bt + (size_t)nxt.pn * tstep : cB;
        for (int t = 0; t < nt; t += 2) {
            const bool last = (t == nt - 2);
            const char* a1 = cA + (size_t)(t + 1) * kstep;
            const char* a2 = last ? nA : cA + (size_t)(t + 2) * kstep; const char* b2 = last ? nB : cB + (size_t)(t + 2) * kstep;
            const char* a3 = a2 + kstep; const char* b3 = b2 + kstep;
            if constexpr (MID) { if (t == nt / 2) E.mid(acc, cur, wr, wc, fr, fq); }
            PG8_LDB(B0, 0, 0); PG8_LDB(B1, 0, 1); PG8_SCHED; PG8_LDA(At, 0, 0); PG8_STAGE(PG8_SA(1, 1), a1 + hstep, voffA);
            PG8_WAIT_V(8); PG8_WAIT_L(0); PG8_BAR; PG8_MMA(0, 0, At, B0); PG8_MMA(0, 1, At, B1); PG8_BAR; PG8_SCHED;
            PG8_LDA(At, 0, 1); PG8_STAGE(PG8_SB(0, 0), b2, voffB); PG8_STAGE(PG8_SB(0, 1), b2 + hstep, voffB); PG8_STAGE(PG8_SA(0, 0), a2, voffA);
            PG8_WAIT_V(8); PG8_WAIT_L(0); PG8_BAR; PG8_MMA(1, 0, At, B0); PG8_MMA(1, 1, At, B1); PG8_BAR; PG8_SCHED;
            PG8_LDB(B0, 1, 0); PG8_LDB(B1, 1, 1); PG8_SCHED; PG8_LDA(At, 1, 0); PG8_STAGE(PG8_SA(0, 1), a2 + hstep, voffA);
            PG8_WAIT_V(8); PG8_WAIT_L(0); PG8_BAR; PG8_MMA(0, 0, At, B0); PG8_MMA(0, 1, At, B1); PG8_BAR; PG8_SCHED;
            PG8_LDA(At, 1, 1); PG8_STAGE(PG8_SB(1, 0), b3, voffB); PG8_STAGE(PG8_SB(1, 1), b3 + hstep, voffB); PG8_STAGE(PG8_SA(1, 0), a3, voffA);
            PG8_WAIT_V(8); PG8_WAIT_L(0); PG8_BAR; PG8_MMA(1, 0, At, B0); PG8_MMA(1, 1, At, B1); PG8_BAR; PG8_SCHED;
        }
        if (wr == 0) PG8_BAR;
        E(acc, cur, wr, wc, fr, fq);
        if (!has_next) break;
#pragma unroll
        for (int a = 0; a < 2; ++a)
#pragma unroll
            for (int b = 0; b < 2; ++b)
#pragma unroll
                for (int m = 0; m < 4; ++m)
#pragma unroll
                    for (int n = 0; n < 2; ++n) acc[a][b][m][n] = (f32x4){0.f, 0.f, 0.f, 0.f};
        cur = nxt; cA = nA; cB = nB; ++ui;
        if (wr == 1) PG8_BAR;
    }
    PG8_WAIT_V(0);
    PG8_BAR;
#undef PG8_SA
#undef PG8_SB
#undef PG8_STAGE
#undef PG8_LDA
#undef PG8_LDB
#undef PG8_MMA
#undef PG8_WAIT_V
#undef PG8_WAIT_L
#undef PG8_BAR
#undef PG8_SCHED
}
}

__device__ __forceinline__ int col_nat(int bj, int wc, int fq) { return 128 * bj + 32 * wc + 8 * fq; }
__device__ __forceinline__ int col_inp(int bj, int wc, int fq) { return 64 * wc + 16 * fq + 8 * bj; }

struct EpiIn {
    bf16_t *Q, *K, *V, *U, *G; const float *rstd, *qg, *kg, *bgate;
    __device__ __forceinline__ void operator()(const f32x4 (&acc)[2][2][4][2], const pg8::Unit& u, int wr, int wc, int fr, int fq) const {
        const int pn = u.pn; const int row0 = u.pm * 256 + wr * 64 + fr;
        if (pn < 4) {
            const bool isq = pn < 2; const float* g = isq ? qg : kg; bf16_t* dst = isq ? Q : K; const int colt = (pn & 1) * 256;
            const float post = isq ? C2 : 1.0f;
#pragma unroll
            for (int ai = 0; ai < 2; ++ai)
#pragma unroll
                for (int m = 0; m < 4; ++m) {
                    const int r = row0 + ai * 128 + m * 16; const float rs = rstd[r];
                    f32x4 v[2][2]; float ss = 0.f;
#pragma unroll
                    for (int bj = 0; bj < 2; ++bj)
#pragma unroll
                        for (int n = 0; n < 2; ++n) { v[bj][n] = acc[ai][bj][m][n] * rs; const f32x4 x = v[bj][n]; ss += (x[0] * x[0] + x[1] * x[1]) + (x[2] * x[2] + x[3] * x[3]); }
                    ss += __shfl_xor(ss, 16); ss += __shfl_xor(ss, 32);
                    const float sc = __builtin_amdgcn_rsqf(ss * (1.0f / 64.0f) + EPS) * post;
#pragma unroll
                    for (int bj = 0; bj < 2; ++bj) {
                        const f32x4 g0 = *(const f32x4*)(g + 16 * fq + 8 * bj), g1 = *(const f32x4*)(g + 16 * fq + 8 * bj + 4);
                        const f32x4 a = v[bj][0] * sc * g0, b = v[bj][1] * sc * g1;
                        u32x4 w; w.x = pk2(a[0], a[1]); w.y = pk2(a[2], a[3]); w.z = pk2(b[0], b[1]); w.w = pk2(b[2], b[3]);
                        u32x4* dp = (u32x4*)(dst + (size_t)r * 512 + colt + col_inp(bj, wc, fq));
                        if (isq) __builtin_nontemporal_store(w, dp); else *dp = w;
                    }
                }
        } else if (pn < 8) {
            bf16_t* dst = pn < 6 ? V : U; const int colt = (pn & 1) * 256;
#pragma unroll
            for (int ai = 0; ai < 2; ++ai)
#pragma unroll
                for (int m = 0; m < 4; ++m) {
                    const int r = row0 + ai * 128 + m * 16; const float rs = rstd[r];
#pragma unroll
                    for (int bj = 0; bj < 2; ++bj) {
                        const f32x4 a = acc[ai][bj][m][0] * rs, b = acc[ai][bj][m][1] * rs;
                        u32x4 w; w.x = pk2(a[0], a[1]); w.y = pk2(a[2], a[3]); w.z = pk2(b[0], b[1]); w.w = pk2(b[2], b[3]);
                        *(u32x4*)(dst + (size_t)r * 512 + colt + col_inp(bj, wc, fq)) = w;
                    }
                }
        } else {
            const int colt = (pn - 8) * 256;
            unsigned char* G8 = (unsigned char*)G;
#pragma unroll
            for (int ai = 0; ai < 2; ++ai)
#pragma unroll
                for (int m = 0; m < 4; ++m) {
                    const int r = row0 + ai * 128 + m * 16; const float rs = rstd[r];
                    u32x4 w;
#pragma unroll
                    for (int bj = 0; bj < 2; ++bj) {
                        const float* bp = bgate + colt + col_inp(bj, wc, fq);
                        const f32x4 a = acc[ai][bj][m][0] * rs + *(const f32x4*)bp, b = acc[ai][bj][m][1] * rs + *(const f32x4*)(bp + 4);
                        unsigned lo = 0u, hi = 0u;
#pragma unroll
                        for (int e = 0; e < 4; ++e) {
                            const unsigned qa = (unsigned)fminf(fmaxf(fast_sigmoid(a[e]) * 255.0f + 0.5f, 1.0f), 255.0f);
                            const unsigned qb = (unsigned)fminf(fmaxf(fast_sigmoid(b[e]) * 255.0f + 0.5f, 1.0f), 255.0f);
                            lo |= qa << (8 * e); hi |= qb << (8 * e);
                        }
                        if (bj == 0) { w.x = lo; w.y = hi; } else { w.z = lo; w.w = hi; }
                    }
                    __builtin_nontemporal_store(w, (u32x4*)(G8 + (size_t)r * 2048 + colt + col_inp(0, wc, fq)));
                }
        }
    }
};

struct EpiGlu {
    const bf16_t* Z; bf16_t* S; const float* bglu;
    __device__ __forceinline__ void operator()(const f32x4 (&acc)[2][2][4][2], const pg8::Unit& u, int wr, int wc, int fr, int fq) const {
        const int row0 = u.pm * 256 + wr * 64 + fr; const int colt = u.pn * 256;
#pragma unroll
        for (int bj = 0; bj < 2; ++bj) {
            const int c = colt + col_nat(bj, wc, fq);
            const f32x4 b0 = *(const f32x4*)(bglu + c), b1 = *(const f32x4*)(bglu + c + 4);
#pragma unroll
            for (int ai = 0; ai < 2; ++ai)
#pragma unroll
                for (int m = 0; m < 4; ++m) {
                    const int r = row0 + ai * 128 + m * 16;
                    const u32x4 z = *(const u32x4*)(Z + (size_t)r * 512 + c);
                    const f32x4 a = acc[ai][bj][m][0] + b0, b = acc[ai][bj][m][1] + b1;
                    u32x4 w;
                    w.x = pk2(bf_lo(z.x) * fast_sigmoid(a[0]), bf_hi(z.x) * fast_sigmoid(a[1]));
                    w.y = pk2(bf_lo(z.y) * fast_sigmoid(a[2]), bf_hi(z.y) * fast_sigmoid(a[3]));
                    w.z = pk2(bf_lo(z.z) * fast_sigmoid(b[0]), bf_hi(z.z) * fast_sigmoid(b[1]));
                    w.w = pk2(bf_lo(z.w) * fast_sigmoid(b[2]), bf_hi(z.w) * fast_sigmoid(b[3]));
                    *(u32x4*)(S + (size_t)r * 1024 + 512 + c) = w;
                }
        }
    }
};

struct EpiMergeH {
    const unsigned char* G; bf16_t* Mg;
    __device__ __forceinline__ void mid(f32x4 (&acc)[2][2][4][2], const pg8::Unit& u, int wr, int wc, int fr, int fq) const {
        asm volatile("" : "+v"(fr), "+v"(fq));
        const int row0 = u.pm * 256 + wr * 64 + fr; const int colt = u.pn * 256;
#pragma unroll
        for (int ai = 0; ai < 2; ++ai)
#pragma unroll
            for (int m = 0; m < 4; ++m) {
                const int r = row0 + ai * 128 + m * 16;
#pragma unroll
                for (int bj = 0; bj < 2; ++bj) {
                    const int c = colt + col_nat(bj, wc, fq);
                    const u32x2 ga = *(const u32x2*)(G + (size_t)r * 2048 + c), gs = *(const u32x2*)(G + (size_t)r * 2048 + 1024 + c);
                    f32x4 a = acc[ai][bj][m][0], b = acc[ai][bj][m][1];
#pragma unroll
                    for (int e = 0; e < 4; ++e) {
                        a[e] *= (float)((ga.x >> (8 * e)) & 0xffu) * __builtin_amdgcn_rcpf((float)((gs.x >> (8 * e)) & 0xffu));
                        b[e] *= (float)((ga.y >> (8 * e)) & 0xffu) * __builtin_amdgcn_rcpf((float)((gs.y >> (8 * e)) & 0xffu));
                    }
                    acc[ai][bj][m][0] = a; acc[ai][bj][m][1] = b;
                }
                if (m & 1) asm volatile("" ::: "memory");
            }
    }
    __device__ __forceinline__ void operator()(const f32x4 (&acc)[2][2][4][2], const pg8::Unit& u, int wr, int wc, int fr, int fq) const {
        const int row0 = u.pm * 256 + wr * 64 + fr; const int colt = u.pn * 256;
#pragma unroll
        for (int ai = 0; ai < 2; ++ai)
#pragma unroll
            for (int m = 0; m < 4; ++m) {
                const int r = row0 + ai * 128 + m * 16;
#pragma unroll
                for (int bj = 0; bj < 2; ++bj) {
                    const int c = colt + col_nat(bj, wc, fq);
                    const u32x2 gs = *(const u32x2*)(G + (size_t)r * 2048 + 1024 + c);
                    const f32x4 a = acc[ai][bj][m][0], b = acc[ai][bj][m][1];
                    float o[8];
#pragma unroll
                    for (int e = 0; e < 4; ++e) { o[e] = a[e] * ((float)((gs.x >> (8 * e)) & 0xffu) * (1.0f / 255.0f)); o[4 + e] = b[e] * ((float)((gs.y >> (8 * e)) & 0xffu) * (1.0f / 255.0f)); }
                    u32x4 w; w.x = pk2(o[0], o[1]); w.y = pk2(o[2], o[3]); w.z = pk2(o[4], o[5]); w.w = pk2(o[6], o[7]);
                    *(u32x4*)(Mg + (size_t)r * 1024 + c) = w;
                }
            }
    }
};

struct EpiOut {
    const bf16_t* X; bf16_t* X1B; float* rss;
    __device__ __forceinline__ void operator()(const f32x4 (&acc)[2][2][4][2], const pg8::Unit& u, int wr, int wc, int fr, int fq) const {
        const int row0 = u.pm * 256 + wr * 64 + fr; const int colt = u.pn * 256;
#pragma unroll
        for (int ai = 0; ai < 2; ++ai)
#pragma unroll
            for (int m = 0; m < 4; ++m) {
                const int r = row0 + ai * 128 + m * 16; float ss = 0.f;
#pragma unroll
                for (int bj = 0; bj < 2; ++bj) {
                    const int c = colt + col_nat(bj, wc, fq);
                    const u32x4 xv = *(const u32x4*)(X + (size_t)r * 1024 + c);
                    const f32x4 a0 = acc[ai][bj][m][0], a1 = acc[ai][bj][m][1];
                    f32x4 a, b;
                    a[0] = bf_lo(xv.x) + a0[0]; a[1] = bf_hi(xv.x) + a0[1]; a[2] = bf_lo(xv.y) + a0[2]; a[3] = bf_hi(xv.y) + a0[3];
                    b[0] = bf_lo(xv.z) + a1[0]; b[1] = bf_hi(xv.z) + a1[1]; b[2] = bf_lo(xv.w) + a1[2]; b[3] = bf_hi(xv.w) + a1[3];
                    ss += (a[0] * a[0] + a[1] * a[1]) + (a[2] * a[2] + a[3] * a[3]) + (b[0] * b[0] + b[1] * b[1]) + (b[2] * b[2] + b[3] * b[3]);
                    u32x4 w; w.x = pk2(a[0], a[1]); w.y = pk2(a[2], a[3]); w.z = pk2(b[0], b[1]); w.w = pk2(b[2], b[3]);
                    *(u32x4*)(X1B + (size_t)r * 1024 + c) = w;
                }
                ss += __shfl_xor(ss, 16); ss += __shfl_xor(ss, 32);
                if (fq == 0) atomicAdd(rss + r, ss);
            }
    }
};

struct EpiMlpIn {
    const float* rss; bf16_t* H;
    __device__ __forceinline__ void operator()(const f32x4 (&acc)[2][2][4][2], const pg8::Unit& u, int wr, int wc, int fr, int fq) const {
        const int row0 = u.pm * 256 + wr * 64 + fr; const int colt = u.pn * 256;
#pragma unroll
        for (int ai = 0; ai < 2; ++ai)
#pragma unroll
            for (int m = 0; m < 4; ++m) {
                const int r = row0 + ai * 128 + m * 16; const float rs = __builtin_amdgcn_rsqf(rss[r] * (1.0f / 1024.0f) + EPS);
#pragma unroll
                for (int bj = 0; bj < 2; ++bj) {
                    f32x4 a = acc[ai][bj][m][0] * rs, b = acc[ai][bj][m][1] * rs;
#pragma unroll
                    for (int e = 0; e < 4; ++e) { a[e] = fmaxf(a[e], 0.f); a[e] *= a[e]; b[e] = fmaxf(b[e], 0.f); b[e] *= b[e]; }
                    u32x4 w; w.x = pk2(a[0], a[1]); w.y = pk2(a[2], a[3]); w.z = pk2(b[0], b[1]); w.w = pk2(b[2], b[3]);
                    *(u32x4*)(H + (size_t)r * 4096 + colt + col_nat(bj, wc, fq)) = w;
                }
            }
    }
};

struct EpiMlpOut {
    const bf16_t* X1B; float* O;
    __device__ __forceinline__ void operator()(const f32x4 (&acc)[2][2][4][2], const pg8::Unit& u, int wr, int wc, int fr, int fq) const {
        const int row0 = u.pm * 256 + wr * 64 + fr; const int colt = u.pn * 256;
#pragma unroll
        for (int ai = 0; ai < 2; ++ai)
#pragma unroll
            for (int m = 0; m < 4; ++m) {
                const int r = row0 + ai * 128 + m * 16;
#pragma unroll
                for (int bj = 0; bj < 2; ++bj) {
                    const int c = colt + col_nat(bj, wc, fq);
                    const u32x4 xv = *(const u32x4*)(X1B + (size_t)r * 1024 + c);
                    const f32x4 a0 = acc[ai][bj][m][0], a1 = acc[ai][bj][m][1];
                    f32x4 a, b;
                    a[0] = bf_lo(xv.x) + a0[0]; a[1] = bf_hi(xv.x) + a0[1]; a[2] = bf_lo(xv.y) + a0[2]; a[3] = bf_hi(xv.y) + a0[3];
                    b[0] = bf_lo(xv.z) + a1[0]; b[1] = bf_hi(xv.z) + a1[1]; b[2] = bf_lo(xv.w) + a1[2]; b[3] = bf_hi(xv.w) + a1[3];
                    float* op = O + (size_t)r * 1024 + c;
                    __builtin_nontemporal_store(a, (f32x4*)op); __builtin_nontemporal_store(b, (f32x4*)(op + 4));
                }
            }
    }
};

namespace att {
constexpr int KOFF = 0, VOFF = 49152, TILEB = 16384;
__device__ __forceinline__ unsigned off_b(unsigned row, unsigned ch) { return 256u * row + 16u * (ch ^ (((row & 3u) << 2) | ((row >> 2) & 3u))); }
__device__ __forceinline__ int crow(int r, int hi) { return (r & 3) + 8 * (r >> 2) + 4 * hi; }
__device__ __forceinline__ s16x4 vtr(const LAS unsigned char* p) { return __builtin_bit_cast(s16x4, __builtin_amdgcn_ds_read_tr16_b64_v4i16((LAS s16x4*)p)); }

__device__ __forceinline__ void glds16(const void* gsrc, unsigned lds_dst) { unsigned keep;
    asm volatile("s_mov_b32 %0, m0\n\ts_mov_b32 m0, %2\n\ts_nop 0\n\tglobal_load_lds_dwordx4 %1, off\n\ts_mov_b32 m0, %0" : "=&s"(keep) : "v"(gsrc), "s"(lds_dst) : "memory"); }
__device__ __forceinline__ void scores_exp(const LAS unsigned char* Kb, const bf16x8 (&q)[4], const unsigned (&ka)[4], float negM, f32x16& sA, f32x16& sB) {
#pragma unroll
    for (int r = 0; r < 16; ++r) { sA[r] = 0.f; sB[r] = 0.f; }
#pragma unroll
    for (int s = 0; s < 4; ++s) {
        const bf16x8 kA = *(const LAS bf16x8*)(Kb + ka[s]);
        const bf16x8 kB = *(const LAS bf16x8*)(Kb + ka[s] + 8192);
        sA = __builtin_amdgcn_mfma_f32_32x32x16_bf16(kA, q[s], sA, 0, 0, 0);
        sB = __builtin_amdgcn_mfma_f32_32x32x16_bf16(kB, q[s], sB, 0, 0, 0);
    }
#pragma unroll
    for (int r = 0; r < 16; ++r) { sA[r] = __builtin_amdgcn_exp2f(sA[r]); sB[r] = __builtin_amdgcn_exp2f(sB[r]); }
}
__device__ __forceinline__ float sum16(const f32x16& a, const f32x16& b) {
    float s0 = a[0] + b[0], s1 = a[1] + b[1], s2 = a[2] + b[2], s3 = a[3] + b[3];
#pragma unroll
    for (int r = 4; r < 16; r += 4) { s0 += a[r] + b[r]; s1 += a[r + 1] + b[r + 1]; s2 += a[r + 2] + b[r + 2]; s3 += a[r + 3] + b[r + 3]; }
    return (s0 + s1) + (s2 + s3);
}

__device__ __forceinline__ void attn_unit(int b, int h, int qb, const bf16_t* Q, const bf16_t* K, const bf16_t* V, bf16_t* O, LAS unsigned char* lds,
                                          float lam, float negM, const float* subg) {
    int tid = threadIdx.x; asm volatile("" : "+v"(tid));
    const int lane = tid & 63, r32 = lane & 31, hi = lane >> 5; const int wid = __builtin_amdgcn_readfirstlane(tid >> 6);
    const size_t rowbase = (size_t)b * SEQ; const int q0 = qb * 256;
    const int ntiles = 4 * qb + 4, mytiles = 4 * qb + (wid >> 1) + 1;
    unsigned goff[2];
#pragma unroll
    for (int i = 0; i < 2; ++i) { const unsigned row = 8 * wid + 4 * i + (lane >> 4), cp = lane & 15, ch = cp ^ (((row & 3u) << 2) | ((row >> 2) & 3u));
        goff[i] = (row * 512 + h * 128 + ch * 8) * 2u; }
    const char* Kh = (const char*)(K + rowbase * 512); const char* Vh = (const char*)(V + rowbase * 512);
    const unsigned lds0 = (unsigned)(uintptr_t)lds;
#define ATT_DMA_K(t, slot) do { const size_t tb_ = (size_t)(t) * 64 * 512 * 2; _Pragma("unroll") for (int i_ = 0; i_ < 2; ++i_) \
        glds16(Kh + tb_ + goff[i_], (unsigned)__builtin_amdgcn_readfirstlane(lds0 + KOFF + (slot) * TILEB + (8 * wid + 4 * i_) * 256)); } while (0)
#define ATT_DMA_V(t, slot) do { const size_t tb_ = (size_t)(t) * 64 * 512 * 2; _Pragma("unroll") for (int i_ = 0; i_ < 2; ++i_) \
        glds16(Vh + tb_ + goff[i_], (unsigned)__builtin_amdgcn_readfirstlane(lds0 + VOFF + (slot) * TILEB + (8 * wid + 4 * i_) * 256)); } while (0)
    const bf16_t* Qw = Q + (rowbase + q0 + wid * 32 + r32) * 512 + h * 128;
    bf16x8 q1[4], q2[4];
#pragma unroll
    for (int s = 0; s < 4; ++s) { q1[s] = *(const bf16x8*)(Qw + 16 * s + 8 * hi); q2[s] = *(const bf16x8*)(Qw + 64 + 16 * s + 8 * hi); }
    unsigned ka1[4], ka2[4];
#pragma unroll
    for (int s = 0; s < 4; ++s) { ka1[s] = off_b(r32, 2 * s + hi); ka2[s] = off_b(r32, 8 + 2 * s + hi); }
    asm volatile("s_waitcnt vmcnt(0)" : "+v"(q1[0]), "+v"(q1[1]), "+v"(q1[2]), "+v"(q1[3]), "+v"(q2[0]), "+v"(q2[1]), "+v"(q2[2]), "+v"(q2[3]) :: "memory");
    float l1 = 0.f, l2 = 0.f;
    ATT_DMA_K(0, 0); ATT_DMA_K(1, 1);
    {
        int slot = 0, slot2 = 2;
        for (int t = 0; t < ntiles; ++t) {
            if (t + 1 < ntiles) asm volatile("s_waitcnt vmcnt(2)" ::: "memory"); else asm volatile("s_waitcnt vmcnt(0)" ::: "memory");
            __builtin_amdgcn_s_barrier();
            if (t + 2 < ntiles) ATT_DMA_K(t + 2, slot2);
            if (t < mytiles) {
                const LAS unsigned char* Kb = lds + KOFF + slot * TILEB;
                f32x16 sA, sB;
                scores_exp(Kb, q1, ka1, negM, sA, sB); l1 += sum16(sA, sB);
                scores_exp(Kb, q2, ka2, negM, sA, sB); l2 += sum16(sA, sB);
            }
            slot = (slot == 2) ? 0 : slot + 1; slot2 = (slot2 == 2) ? 0 : slot2 + 1;
        }
    }
    l1 += __shfl_xor(l1, 32); l2 += __shfl_xor(l2, 32);
    const float i1 = __builtin_amdgcn_rcpf(l1), i2 = lam * __builtin_amdgcn_rcpf(l2);
    asm volatile("s_waitcnt lgkmcnt(0)" ::: "memory");
    __builtin_amdgcn_s_barrier();
    f32x16 o[4];
#pragma unroll
    for (int c = 0; c < 4; ++c)
#pragma unroll
        for (int r = 0; r < 16; ++r) o[c][r] = 0.f;
    const unsigned blk = (lane >> 4) & 1, qq = (lane & 15) >> 2, pp = lane & 3;
    unsigned trb[2];
#pragma unroll
    for (int t = 0; t < 2; ++t) trb[t] = 256u * (8 * t + 4 * hi + qq) + 16u * ((2 * blk + (pp >> 1)) ^ (2 * t + hi)) + 8u * (pp & 1);
    ATT_DMA_K(0, 0); ATT_DMA_V(0, 0); ATT_DMA_K(1, 1); ATT_DMA_V(1, 1);
    {
        int slot = 0, slot2 = 2;
        for (int t = 0; t < ntiles; ++t) {
            if (t + 1 < ntiles) asm volatile("s_waitcnt vmcnt(4)" ::: "memory"); else asm volatile("s_waitcnt vmcnt(0)" ::: "memory");
            __builtin_amdgcn_s_barrier();
            if (t + 2 < ntiles) { ATT_DMA_K(t + 2, slot2); ATT_DMA_V(t + 2, slot2); }
            if (t < mytiles) {
                const LAS unsigned char* Kb = lds + KOFF + slot * TILEB; const LAS unsigned char* Vb = lds + VOFF + slot * TILEB;
                f32x16 pA, pB, rA, rB;
                scores_exp(Kb, q1, ka1, negM, pA, pB);
                scores_exp(Kb, q2, ka2, negM, rA, rB);
#pragma unroll
                for (int r = 0; r < 16; ++r) { pA[r] = pA[r] * i1 - rA[r] * i2; pB[r] = pB[r] * i1 - rB[r] * i2; }
                bf16x8 pa[4];
#pragma unroll
                for (int h2 = 0; h2 < 2; ++h2) {
                    u32x4 wa, wb;
                    wa.x = pk2(pA[8 * h2 + 0], pA[8 * h2 + 1]); wa.y = pk2(pA[8 * h2 + 2], pA[8 * h2 + 3]); wa.z = pk2(pA[8 * h2 + 4], pA[8 * h2 + 5]); wa.w = pk2(pA[8 * h2 + 6], pA[8 * h2 + 7]);
                    wb.x = pk2(pB[8 * h2 + 0], pB[8 * h2 + 1]); wb.y = pk2(pB[8 * h2 + 2], pB[8 * h2 + 3]); wb.z = pk2(pB[8 * h2 + 4], pB[8 * h2 + 5]); wb.w = pk2(pB[8 * h2 + 6], pB[8 * h2 + 7]);
                    pa[h2] = __builtin_bit_cast(bf16x8, wa); pa[2 + h2] = __builtin_bit_cast(bf16x8, wb);
                }
#pragma unroll
                for (int c = 0; c < 4; ++c) {
                    const unsigned cx = 64u * ((unsigned)c ^ qq);
#pragma unroll
                    for (int ks = 0; ks < 4; ++ks) {
                        const s16x4 lo = vtr(Vb + trb[0] + cx + ks * 4096), hi4 = vtr(Vb + trb[1] + cx + ks * 4096);
                        const bf16x8 vf = {lo[0], lo[1], lo[2], lo[3], hi4[0], hi4[1], hi4[2], hi4[3]};
                        o[c] = __builtin_amdgcn_mfma_f32_32x32x16_bf16(pa[ks], vf, o[c], 0, 0, 0);
                    }
                }
            }
            slot = (slot == 2) ? 0 : slot + 1; slot2 = (slot2 == 2) ? 0 : slot2 + 1;
        }
    }
#undef ATT_DMA_K
#undef ATT_DMA_V
    float sg[4];
#pragma unroll
    for (int c = 0; c < 4; ++c) sg[c] = subg[32 * c + r32] * 0.8f;
    bf16_t* Ow = O + (rowbase + q0 + wid * 32) * 1024 + h * 128 + r32;
#pragma unroll
    for (int r = 0; r < 16; ++r) {
        const int qr = crow(r, hi);
        float ss = 0.f;
#pragma unroll
        for (int c = 0; c < 4; ++c) ss += o[c][r] * o[c][r];
        ss += __shfl_xor(ss, 1); ss += __shfl_xor(ss, 2); ss += __shfl_xor(ss, 4); ss += __shfl_xor(ss, 8); ss += __shfl_xor(ss, 16);
        const float sc = __builtin_amdgcn_rsqf(ss * (1.0f / 128.0f) + EPS);
#pragma unroll
        for (int c = 0; c < 4; ++c) { const unsigned w = pk2(o[c][r] * sc * sg[c], 0.f); __builtin_nontemporal_store((bf16_t)(w & 0xffffu), Ow + (size_t)qr * 1024 + 32 * c); }
    }
    asm volatile("s_waitcnt vmcnt(0) lgkmcnt(0)" ::: "memory");
    __builtin_amdgcn_s_barrier();
}
}

constexpr int SSM_XP = 68;
constexpr int SSM_LDP = 132;
constexpr int SSM_WAVE_BYTES = 17408;
template <bool FULL>
__device__ __forceinline__ void ssm_task(int b, int g, int c, unsigned char* ws, const float* Dvec, LAS float* scr, int lane) {
    const float* LBR = (const float*)(ws + WS_SMALL + OFF_LBR); const float* LBI = (const float*)(ws + WS_SMALL + OFF_LBI);
    const bf16x8* BBF = (const bf16x8*)(ws + WS_SMALL + OFF_BBF); const bf16x8* CF = (const bf16x8*)(ws + WS_SMALL + OFF_CF);
    bf16_t* U = (bf16_t*)(ws + WS_U);
    const int r32 = lane & 31, hi = lane >> 5;
    const float lbr = LBR[g * 64 + lane], lbi = LBI[g * 64 + lane];
    const size_t sidx = (((size_t)b * NG + g) * NCH + c) * 128;
    float xr = 0.f, xi = 0.f;
    if (FULL) { const float* CARRY = (const float*)(ws + WS_CARRY); xr = CARRY[sidx + lane]; xi = CARRY[sidx + 64 + lane]; }
    bf16x8 bfr[4];
#pragma unroll
    for (int cb = 0; cb < 4; ++cb) bfr[cb] = BBF[(g * 4 + cb) * 64 + lane];
    bf16x8 cfr[4];
    float dn = 0.f;
    if (FULL) {
#pragma unroll
        for (int s = 0; s < 4; ++s) cfr[s] = CF[(g * 4 + s) * 64 + lane];
        dn = Dvec[16 * g + (lane & 15)];
    }
    const size_t row0 = (size_t)b * SEQ + (size_t)c * 64;
#pragma unroll 1
    for (int jb = 0; jb < 2; ++jb) {
        const bf16x8 ua = *(const bf16x8*)(U + (row0 + 32 * jb + r32) * 512 + 16 * g + 8 * hi);
        bf16_t upre[2][4];
        if (FULL) {
#pragma unroll
            for (int jbb = 0; jbb < 2; ++jbb)
#pragma unroll
                for (int e = 0; e < 4; ++e) upre[jbb][e] = U[(row0 + 32 * jb + 16 * jbb + 4 * (lane >> 4) + e) * 512 + 16 * g + (lane & 15)];
        }
        f32x16 zr0, zr1, zi0, zi1;
#pragma unroll
        for (int r = 0; r < 16; ++r) { zr0[r] = 0.f; zr1[r] = 0.f; zi0[r] = 0.f; zi1[r] = 0.f; }
        zr0 = __builtin_amdgcn_mfma_f32_32x32x16_bf16(ua, bfr[0], zr0, 0, 0, 0);
        zr1 = __builtin_amdgcn_mfma_f32_32x32x16_bf16(ua, bfr[1], zr1, 0, 0, 0);
        zi0 = __builtin_amdgcn_mfma_f32_32x32x16_bf16(ua, bfr[2], zi0, 0, 0, 0);
        zi1 = __builtin_amdgcn_mfma_f32_32x32x16_bf16(ua, bfr[3], zi1, 0, 0, 0);
#pragma unroll
        for (int r = 0; r < 16; ++r) {
            const auto pr = __builtin_amdgcn_permlane32_swap(__float_as_uint(zr0[r]), __float_as_uint(zr1[r]), false, false);
            zr0[r] = __uint_as_float(pr[0]); zr1[r] = __uint_as_float(pr[1]);
            const auto pi = __builtin_amdgcn_permlane32_swap(__float_as_uint(zi0[r]), __float_as_uint(zi1[r]), false, false);
            zi0[r] = __uint_as_float(pi[0]); zi1[r] = __uint_as_float(pi[1]);
        }
#pragma unroll
        for (int j = 0; j < 32; ++j) {
            const int hh = (j >> 2) & 1, rr = (j & 3) + 4 * (j >> 3);
            const float br = hh ? zr1[rr] : zr0[rr], bi = hh ? zi1[rr] : zi0[rr];
            const float nr = lbr * xr - lbi * xi + br, ni = lbr * xi + lbi * xr + bi;
            xr = nr; xi = ni;
            if (FULL) ((LAS unsigned*)scr)[j * SSM_XP + lane] = pk2(xr, xi);
        }
        if (FULL) {
            asm volatile("s_waitcnt lgkmcnt(0)" ::: "memory");
            __builtin_amdgcn_wave_barrier();
            const int n = lane & 15, kq = lane >> 4;
            float zv[2][4];
#pragma unroll
            for (int jbb = 0; jbb < 2; ++jbb) {
                f32x4 y = {0.f, 0.f, 0.f, 0.f};
#pragma unroll
                for (int s = 0; s < 4; ++s) {
                    const bf16x8 xa = *(const LAS bf16x8*)((const LAS unsigned*)scr + (16 * jbb + n) * SSM_XP + 16 * s + 4 * kq);
                    y = __builtin_amdgcn_mfma_f32_16x16x32_bf16(xa, cfr[s], y, 0, 0, 0);
                }
#pragma unroll
                for (int e = 0; e < 4; ++e) {
                    const float uu = __uint_as_float(((unsigned)upre[jbb][e]) << 16);
                    const float yv = y[e] + dn * uu;
                    const float inner = 0.7978845608028654f * (yv + 0.044715f * yv * yv * yv);
                    zv[jbb][e] = yv * fast_sigmoid(2.0f * inner);
                }
            }
            asm volatile("s_waitcnt lgkmcnt(0)" ::: "memory"); __builtin_amdgcn_wave_barrier();
            {
                LAS unsigned char* sb = (LAS unsigned char*)scr;
#pragma unroll
                for (int jbb = 0; jbb < 2; ++jbb)
#pragma unroll
                    for (int e = 0; e < 4; ++e) *(LAS bf16_t*)(sb + (16 * jbb + 4 * kq + e) * 32 + n * 2) = (bf16_t)(pk2(zv[jbb][e], 0.f) & 0xffffu);
                asm volatile("s_waitcnt lgkmcnt(0)" ::: "memory"); __builtin_amdgcn_wave_barrier();
                const u32x4 zz = *(const LAS u32x4*)(sb + (lane >> 1) * 32 + (lane & 1) * 16);
                *(u32x4*)(U + (row0 + 32 * jb + (lane >> 1)) * 512 + 16 * g + 8 * (lane & 1)) = zz;
            }
            asm volatile("s_waitcnt lgkmcnt(0)" ::: "memory");
            __builtin_amdgcn_wave_barrier();
        }
    }
    if (!FULL) { float* SEND = (float*)(ws + WS_SEND); SEND[sidx + lane] = xr; SEND[sidx + 64 + lane] = xi; }
}

template <bool HASG>
__device__ __forceinline__ void p0_transpose_item(const float* W, int K, int N, bf16_t* WT, bool permw, const float* gk, LAS float* scr, int item, int lane, int ldk = 0, int koff = 0) {
    if (ldk == 0) ldk = K;
    const int nblk = N / 32, kb = item / nblk, nb = item % nblk, k0 = 64 * kb, n0 = 32 * nb;
    float v[32]; float gv[32];
    const float* wp = W + (size_t)(k0 + (lane >> 5)) * N + n0 + (lane & 31);
#pragma unroll
    for (int i = 0; i < 32; ++i) { v[i] = __builtin_nontemporal_load(wp + (size_t)(2 * i) * N); if (HASG) gv[i] = gk[k0 + 2 * i + (lane >> 5)]; }
    asm volatile("" ::: "memory");
#pragma unroll
    for (int i = 0; i < 32; ++i) { const int kk = 2 * i + (lane >> 5); scr[kk * 33 + (lane & 31)] = HASG ? v[i] * gv[i] : v[i]; }
    asm volatile("s_waitcnt lgkmcnt(0)" ::: "memory"); __builtin_amdgcn_wave_barrier();
    int p0 = n0;
    const int c = lane & 7;
#pragma unroll
    for (int j = 0; j < 4; ++j) { const int n = (lane >> 3) + 8 * j; const LAS float* s = scr + (8 * c) * 33 + n;
        u32x4 o; o.x = pk2(s[0 * 33], s[1 * 33]); o.y = pk2(s[2 * 33], s[3 * 33]); o.z = pk2(s[4 * 33], s[5 * 33]); o.w = pk2(s[6 * 33], s[7 * 33]);
        int prow = p0 + n;
        if (permw) { const int lam_ = n0 + n, pn = lam_ >> 8, w = (lam_ >> 6) & 3, f = (lam_ >> 4) & 3, bb = (lam_ >> 3) & 1, jj = lam_ & 7; prow = pn * 256 + bb * 128 + w * 32 + f * 8 + jj; }
        u32x4* wp_ = (u32x4*)(WT + (size_t)prow * ldk + koff + k0 + 8 * c);
        if (permw) *wp_ = o; else __builtin_nontemporal_store(o, wp_); }
    asm volatile("s_waitcnt lgkmcnt(0)" ::: "memory"); __builtin_amdgcn_wave_barrier();
}

__device__ __forceinline__ void sincos_d(double x, double& s, double& c) {
    const double TWO_PI = 6.283185307179586476925;
    const double k = __builtin_rint(x / TWO_PI); const double r = x - k * TWO_PI; const double r2 = r * r;
    double ts = 1.0, tc = 1.0;
#pragma unroll 1
    for (int n = 16; n >= 1; --n) { ts = 1.0 - ts * r2 / (double)((2 * n) * (2 * n + 1)); tc = 1.0 - tc * r2 / (double)((2 * n - 1) * (2 * n)); }
    s = r * ts; c = tc;
}

#define RLX_AGENT __ATOMIC_RELAXED, __HIP_MEMORY_SCOPE_AGENT
#define XB_TMO      128
#define XB_XCNT(j)  (256  + 64 * (j))
#define XB_XSUB(j)  (1280 + 64 * (j))
#define XB_XGEN(j)  (2304 + 64 * (j))
#define XB_TOP      3328
#define XB_TOPGEN   3392
#define XCD_BAR_WORDS 3456
#define XB_SPIN_CAP (1u << 20)
__device__ __forceinline__ unsigned xb_ld(unsigned* p)              { return __hip_atomic_load(p, __ATOMIC_RELAXED, __HIP_MEMORY_SCOPE_AGENT); }
__device__ __forceinline__ unsigned xb_add(unsigned* p, unsigned v) { return __hip_atomic_fetch_add(p, v, __ATOMIC_RELAXED, __HIP_MEMORY_SCOPE_AGENT); }
__device__ __forceinline__ unsigned xb_xcc_id() { return (unsigned)__builtin_amdgcn_s_getreg((3 << 11) | 20) & 0xFu; }
#define XB_SPIN(cond, bar) do { unsigned _sp = 0; while (cond) { __builtin_amdgcn_s_sleep(1); \
    if ((++_sp & 255u) == 0u) { if (xb_ld(&(bar)[XB_TMO])) break; if (_sp > XB_SPIN_CAP) { atomicAdd(&(bar)[XB_TMO], 1u); break; } } } } while (0)
struct XcdBarrier { unsigned* bar; unsigned x; volatile LAS unsigned* st; };
__device__ __forceinline__ XcdBarrier xcd_barrier_post(unsigned* bar, volatile LAS unsigned* st) {
    XcdBarrier b; b.bar = bar; b.x = xb_xcc_id(); b.st = st;
    if (threadIdx.x == 0) (void)xb_add(&bar[XB_XCNT(b.x)], 1u);
    return b;
}
__device__ __forceinline__ void xcd_barrier_complete(unsigned* bar, unsigned x, unsigned& nloc, unsigned& nx) {
    const unsigned G = gridDim.x * gridDim.y * gridDim.z;
    unsigned sum, cnt, mine, sp = 0u;
    for (;;) {
        sum = 0u; cnt = 0u; mine = 0u;
#pragma unroll
        for (unsigned j = 0; j < 16; ++j) { const unsigned c = xb_ld(&bar[XB_XCNT(j)]); sum += c; cnt += (c > 0u) ? 1u : 0u; mine = (j == x) ? c : mine; }
        if (sum == G) break;
        __builtin_amdgcn_s_sleep(1);
        if ((++sp & 255u) == 0u) { if (xb_ld(&bar[XB_TMO])) break; if (sp > XB_SPIN_CAP) { atomicAdd(&bar[XB_TMO], 1u); break; } }
    }
    nloc = mine > 0u ? mine : 1u; nx = cnt > 0u ? cnt : 1u;
}
__device__ __forceinline__ void xcd_barrier(const XcdBarrier& b) {
    asm volatile("s_waitcnt vmcnt(0)" ::: "memory");
    __syncthreads();
    if (threadIdx.x == 0) {
        unsigned* bar = b.bar;
        __builtin_amdgcn_s_waitcnt(0);
        unsigned nloc = b.st[0], nx = b.st[1];
        if (nloc == 0u) { xcd_barrier_complete(bar, b.x, nloc, nx); b.st[0] = nloc; b.st[1] = nx; }
        const unsigned old = xb_add(&bar[XB_XSUB(b.x)], 1u);
        const unsigned gen = old / nloc;
        if (old + 1u == (gen + 1u) * nloc) {
            __builtin_amdgcn_fence(__ATOMIC_RELEASE, "agent");
            asm volatile("s_waitcnt vmcnt(0)" ::: "memory");
            const unsigned og = xb_add(&bar[XB_TOP], 1u);
            const unsigned tg = og / nx;
            if (og + 1u == (tg + 1u) * nx) xb_add(&bar[XB_TOPGEN], 1u);
            else XB_SPIN(xb_ld(&bar[XB_TOPGEN]) == tg, bar);
            __builtin_amdgcn_fence(__ATOMIC_ACQUIRE, "agent");
            xb_add(&bar[XB_XGEN(b.x)], 1u);
            asm volatile("s_waitcnt vmcnt(0)" ::: "memory");
        } else {
            XB_SPIN(xb_ld(&bar[XB_XGEN(b.x)]) == gen, bar);
            __builtin_amdgcn_fence(__ATOMIC_ACQUIRE, "agent");
            asm volatile("s_waitcnt vmcnt(0)" ::: "memory");
        }
    }
    __syncthreads();
}

struct Params {
    const float *x, *norm_mix_g, *w_in, *b_gate, *q_norm_g, *k_norm_g, *lq1, *lk1, *lq2, *lk2, *subln_g, *a_re, *a_im, *log_dt, *b_re, *b_im, *c_re, *c_im, *ssm_d,
        *w_glu, *b_glu, *w_pa, *w_ps, *w_out, *norm_mlp_g, *w_mi, *w_mo;
    float* out; unsigned char* ws;
};

__global__ void __launch_bounds__(512, 2) mega(Params P) {
    extern __shared__ __attribute__((aligned(16))) unsigned char lds_raw[];
    LAS unsigned char* lds = (LAS unsigned char*)lds_raw;
    cg::grid_group grid = cg::this_grid();
    const int tid = threadIdx.x, lane = tid & 63; const int wid = __builtin_amdgcn_readfirstlane(tid >> 6);
    const int G = gridDim.x, bx = blockIdx.x;
    const int vcu = (G % 8 == 0) ? (bx % 8) * (G / 8) + bx / 8 : bx;
    const int gw = vcu * 8 + wid, NGW = G * 8;
    unsigned char* ws = P.ws;
    volatile LAS unsigned* xst = (volatile LAS unsigned*)(lds + LDS_BYTES - 64);
    if (tid < 16) xst[tid] = 0u;
    __syncthreads();
    XcdBarrier xbar = xcd_barrier_post((unsigned*)ws, xst);
#define Wt_in ((bf16_t*)(ws + WS_W_IN))
#define Wt_mi ((bf16_t*)(ws + WS_W_MI))
#define Wt_mo ((bf16_t*)(ws + WS_W_MO))
#define Wt_out ((bf16_t*)(ws + WS_W_OUT))
#define Wt_pa ((bf16_t*)(ws + WS_W_PA))
#define Wt_ps ((bf16_t*)(ws + WS_W_PS))
#define Wt_glu ((bf16_t*)(ws + WS_W_GLU))
#define QB ((bf16_t*)(ws + WS_Q))
#define KB ((bf16_t*)(ws + WS_K))
#define VB ((bf16_t*)(ws + WS_V))
#define UB ((bf16_t*)(ws + WS_U))
#define GB ((bf16_t*)(ws + WS_G))
#define XB ((bf16_t*)(ws + WS_XB))
#define HB ((bf16_t*)(ws + WS_H))
#define X1B ((bf16_t*)(ws + WS_X1B))
#define AOB ((bf16_t*)(ws + WS_AO))
#define MGB ((bf16_t*)(ws + WS_MG))
#define rstd1 ((float*)(ws + WS_SMALL + OFF_RSTD1))
#define rss2 ((float*)(ws + WS_SMALL + OFF_RSS2))

    {
        LAS float* scr = (LAS float*)(lds + wid * 16384);
        for (int gt = bx * 512 + tid; gt < NG * NP * 16; gt += G * 512) {
            const int gp = gt >> 4, n = gt & 15, g = gp >> 6, p = gp & 63;
            const double dt = exp((double)P.log_dt[g]); const double ar = (double)P.a_re[gp], ai = (double)P.a_im[gp];
            const double mag = exp(ar * dt); double sn, cs; sincos_d(ai * dt, sn, cs);
            const double lr = mag * cs, li = mag * sn; const double den = ar * ar + ai * ai; const double nr = lr - 1.0, ni = li;
            const double fr = (nr * ar + ni * ai) / den, fi = (ni * ar - nr * ai) / den;
            if (n == 0) {
                double pr = lr, pi = li;
#pragma unroll 1
                for (int k = 0; k < 6; ++k) { const double t = pr * pr - pi * pi; pi = 2.0 * pr * pi; pr = t; }
                ((float*)(ws + WS_SMALL + OFF_LBR))[gp] = (float)lr; ((float*)(ws + WS_SMALL + OFF_LBI))[gp] = (float)li;
                ((float*)(ws + WS_SMALL + OFF_A64R))[gp] = (float)pr; ((float*)(ws + WS_SMALL + OFF_A64I))[gp] = (float)pi;
            }
            bf16_t* BBF = (bf16_t*)(ws + WS_SMALL + OFF_BBF);
            const double br = (double)P.b_re[gt], bi = (double)P.b_im[gt];
            const float vre = (float)(fr * br - fi * bi), vim = (float)(fr * bi + fi * br);
            const int hi = n >> 3, e = n & 7, ln = (p & 31) + 32 * hi;
            BBF[(((size_t)g * 4 + (p >> 5)) * 64 + ln) * 8 + e] = (bf16_t)(pk2(vre, 0.f) & 0xffffu);
            BBF[(((size_t)g * 4 + 2 + (p >> 5)) * 64 + ln) * 8 + e] = (bf16_t)(pk2(vim, 0.f) & 0xffffu);
        }
        for (int gt = bx * 512 + tid; gt < NG * 4 * 64 * 8; gt += G * 512) {
            const int e = gt & 7, q = gt >> 3, g = q >> 8, s = (q >> 6) & 3, ln = q & 63, n = ln & 15, kq = ln >> 4;
            bf16_t* CF = (bf16_t*)(ws + WS_SMALL + OFF_CF);
            const int col = 32 * s + 8 * kq + e, pst = col >> 1;
            const float v = (col & 1) ? -P.c_im[((size_t)g * 16 + n) * 64 + pst] : P.c_re[((size_t)g * 16 + n) * 64 + pst];
            CF[gt] = (bf16_t)(pk2(v, 0.f) & 0xffffu);
        }
        constexpr int I_IN = 16 * 128, I_GLU = 8 * 16, I_PA = 8 * 32, I_PS = 8 * 32, I_OUT = 16 * 32, I_MI = 16 * 128, I_MO = 64 * 32;
        constexpr int NITEMS = I_IN + I_GLU + I_PA + I_PS + I_OUT + I_MI + I_MO;
        constexpr int NQUAD = TOK / 4;
        for (int it = gw; it < NITEMS + NQUAD; it += NGW) {
            int r = it;
            if (r < I_IN) { p0_transpose_item<true>(P.w_in, 1024, 4096, Wt_in, true, P.norm_mix_g, scr, r, lane); continue; } r -= I_IN;
            if (r < I_GLU) { p0_transpose_item<false>(P.w_glu, 512, 512, Wt_glu, false, nullptr, scr, r, lane); continue; } r -= I_GLU;
            if (r < I_PA) { p0_transpose_item<false>(P.w_pa, 512, 1024, Wt_pa, false, nullptr, scr, r, lane, 1024, 0); continue; } r -= I_PA;
            if (r < I_PS) { p0_transpose_item<false>(P.w_ps, 512, 1024, Wt_pa, false, nullptr, scr, r, lane, 1024, 512); continue; } r -= I_PS;
            if (r < I_OUT) { p0_transpose_item<false>(P.w_out, 1024, 1024, Wt_out, false, nullptr, scr, r, lane); continue; } r -= I_OUT;
            if (r < I_MI) { p0_transpose_item<true>(P.w_mi, 1024, 4096, Wt_mi, false, P.norm_mlp_g, scr, r, lane); continue; } r -= I_MI;
            if (r < I_MO) { p0_transpose_item<false>(P.w_mo, 4096, 1024, Wt_mo, false, nullptr, scr, r, lane); continue; } r -= I_MO;
            const int m0 = 4 * r;
            f32x4 v[4][4];
#pragma unroll
            for (int q = 0; q < 4; ++q) { const f32x4* xr = (const f32x4*)(P.x + (size_t)(m0 + q) * DM) + lane;
#pragma unroll
                for (int j = 0; j < 4; ++j) v[q][j] = __builtin_nontemporal_load(xr + 64 * j); }
            asm volatile("" ::: "memory");
#pragma unroll
            for (int q = 0; q < 4; ++q) {
                float s = 0.f;
#pragma unroll
                for (int j = 0; j < 4; ++j) s += (v[q][j][0] * v[q][j][0] + v[q][j][1] * v[q][j][1]) + (v[q][j][2] * v[q][j][2] + v[q][j][3] * v[q][j][3]);
                s = wave_sum(s);
                u32x2* o8 = (u32x2*)(XB + (size_t)(m0 + q) * DM) + lane;
#pragma unroll
                for (int j = 0; j < 4; ++j) { u32x2 w; w.x = pk2(v[q][j][0], v[q][j][1]); w.y = pk2(v[q][j][2], v[q][j][3]); o8[64 * j] = w; }
                if (lane == 0) { rstd1[m0 + q] = 1.0f / sqrtf(s * (1.0f / 1024.0f) + EPS); rss2[m0 + q] = 0.f; }
            }
        }
    }
    if (__builtin_expect(P.out == nullptr, 0)) grid.sync();
    xcd_barrier(xbar);

    if (PHMASK & 2) {
        pg8::Gemm g{XB, Wt_in, TOK, INC, DM}; pg8::StaticOrder S; S.init(TOK, INC, G, bx);
        EpiIn E{QB, KB, VB, UB, GB, rstd1, P.q_norm_g, P.k_norm_g, P.b_gate};
        pg8::gemm_phase<EpiIn, pg8::StaticOrder>(lds, g, S, E);
    }
    xcd_barrier(xbar);

    if (PHMASK & 4) {
        LAS float* scr = (LAS float*)(lds + wid * SSM_WAVE_BYTES);
        for (int it = gw; it < BATCH * NG * NCH; it += NGW) { const int c = it & 63, g = (it >> 6) & 31, b = it >> 11; ssm_task<false>(b, g, c, ws, P.ssm_d, scr, lane); }
        __syncthreads();
        const float d1 = wave_sum(P.lq1[lane] * P.lk1[lane]), d2 = wave_sum(P.lq2[lane] * P.lk2[lane]);
        const float lam = __builtin_amdgcn_exp2f(d1 * 1.4426950408889634f) - __builtin_amdgcn_exp2f(d2 * 1.4426950408889634f) + 0.2f;
        const float gqm = wave_max(fabsf(P.q_norm_g[lane])), gkm = wave_max(fabsf(P.k_norm_g[lane]));
        const float negM = 0.0f; (void)gqm; (void)gkm;
        for (int i = 0;; ++i) {
            const int idx = vcu + i * G; if (idx >= 512) break;
            const int pr = idx & 255, second = idx >> 8, bh = pr >> 3, s = pr & 7, qb = second ? 15 - s : s;
            att::attn_unit(bh >> 2, bh & 3, qb, QB, KB, VB, AOB, lds, lam, negM, P.subln_g);
        }
    }
    xcd_barrier(xbar);

    if ((PHMASK & 8) && wid == 0) {
        const float* SEND = (const float*)(ws + WS_SEND); float* CARRY = (float*)(ws + WS_CARRY);
        for (int bg = bx; bg < BATCH * NG; bg += G) {
            const int g = bg & 31;
            const float ar = ((const float*)(ws + WS_SMALL + OFF_A64R))[g * 64 + lane], ai = ((const float*)(ws + WS_SMALL + OFF_A64I))[g * 64 + lane];
            float xr = 0.f, xi = 0.f; const size_t base = (size_t)bg * NCH * 128;
#pragma unroll 1
            for (int c0 = 0; c0 < NCH; c0 += 32) {
                float sr[32], si[32];
#pragma unroll
                for (int c = 0; c < 32; ++c) { sr[c] = SEND[base + (c0 + c) * 128 + lane]; si[c] = SEND[base + (c0 + c) * 128 + 64 + lane]; }
                asm volatile("" ::: "memory");
#pragma unroll
                for (int c = 0; c < 32; ++c) {
                    CARRY[base + (c0 + c) * 128 + lane] = xr; CARRY[base + (c0 + c) * 128 + 64 + lane] = xi;
                    const float nr = ar * xr - ai * xi + sr[c], ni = ar * xi + ai * xr + si[c]; xr = nr; xi = ni;
                }
            }
        }
    }
    xcd_barrier(xbar);

    if (PHMASK & 16) {
        LAS float* scr = (LAS float*)(lds + wid * SSM_WAVE_BYTES);
        for (int it = gw; it < BATCH * NG * NCH; it += NGW) { const int c = it & 63, g = (it >> 6) & 31, b = it >> 11; ssm_task<true>(b, g, c, ws, P.ssm_d, scr, lane); }
    }
    xcd_barrier(xbar);

    if (PHMASK & 32) {
        pg8::Gemm g{UB, Wt_glu, TOK, 512, 512}; pg8::StaticOrder S; S.init(TOK, 512, G, bx);
        EpiGlu E{UB, AOB, P.b_glu};
        pg8::gemm_phase<EpiGlu, pg8::StaticOrder>(lds, g, S, E);
    }
    xcd_barrier(xbar);

    if (PHMASK & 64) {
        pg8::Gemm g{AOB, Wt_pa, TOK, 1024, 1024}; pg8::StaticOrder S; S.init(TOK, 1024, G, bx);
        EpiMergeH E{(const unsigned char*)GB, MGB};
        pg8::gemm_phase<EpiMergeH, pg8::StaticOrder, true>(lds, g, S, E);
    }
    xcd_barrier(xbar);

    if (PHMASK & 128) {
        pg8::Gemm g{MGB, Wt_out, TOK, 1024, 1024}; pg8::StaticOrder S; S.init(TOK, 1024, G, bx);
        EpiOut E{XB, X1B, rss2};
        pg8::gemm_phase<EpiOut, pg8::StaticOrder>(lds, g, S, E);
    }
    xcd_barrier(xbar);

    for (int hf_ = 0; hf_ < 2; ++hf_) {
        const size_t r0 = (size_t)hf_ * (TOK / 2);
        if (PHMASK & 256) {
            pg8::Gemm g{X1B + r0 * 1024, Wt_mi, TOK / 2, FF, 1024}; pg8::StaticOrder S; S.init(TOK / 2, FF, G, bx);
            EpiMlpIn E{rss2 + r0, HB + r0 * 4096};
            pg8::gemm_phase<EpiMlpIn, pg8::StaticOrder>(lds, g, S, E);
        }
        xcd_barrier(xbar);
        if (PHMASK & 512) {
            pg8::Gemm g{HB + r0 * 4096, Wt_mo, TOK / 2, 1024, FF}; pg8::StaticOrder S; S.init(TOK / 2, 1024, G, bx);
            EpiMlpOut E{X1B + r0 * 1024, P.out + r0 * 1024};
            pg8::gemm_phase<EpiMlpOut, pg8::StaticOrder>(lds, g, S, E);
        }
        if (hf_ == 0) xcd_barrier(xbar);
    }
}

extern "C" void kernel_launch(void* const* d_in, const int* in_sizes, int n_in, void* d_out, int out_size, void* d_ws, size_t ws_size, hipStream_t stream) {
    static int grid = 0;
    if (grid == 0) {
        if (n_in != 27 || ws_size < WS_END) { fprintf(stderr, "kernel_launch: unexpected n_in %d or ws_size %zu\n", n_in, ws_size); grid = -1; return; }
        int dev = 0, cus = 0, per_cu = 0;
        hipGetDevice(&dev); hipDeviceGetAttribute(&cus, hipDeviceAttributeMultiprocessorCount, dev);
        if (hipFuncSetAttribute((const void*)mega, hipFuncAttributeMaxDynamicSharedMemorySize, LDS_BYTES) != hipSuccess) { fprintf(stderr, "kernel_launch: hipFuncSetAttribute failed\n"); }
        if (hipOccupancyMaxActiveBlocksPerMultiprocessor(&per_cu, (const void*)mega, 512, LDS_BYTES) != hipSuccess || per_cu < 1) { fprintf(stderr, "kernel_launch: occupancy query says %d\n", per_cu); per_cu = 1; }
        (void)hipGetLastError();
        grid = cus;
    }
    if (grid < 0) return;
    Params p{};
    const float** pp = (const float**)&p;
    for (int i = 0; i < 27; ++i) pp[i] = (const float*)d_in[i];
    p.out = (float*)d_out; p.ws = (unsigned char*)d_ws;
    if (hipMemsetAsync(d_ws, 0, 65536, stream) != hipSuccess) { fprintf(stderr, "kernel_launch: memset failed\n"); return; }
    void* args[] = {&p};
    hipError_t e = hipLaunchCooperativeKernel((const void*)mega, dim3(grid), dim3(512), args, LDS_BYTES, stream);
    if (e != hipSuccess) fprintf(stderr, "cooperative launch failed: %s (grid %d)\n", hipGetErrorString(e), grid);
}
```

```cpp
#include <hip/hip_runtime.h>
#include <hip/hip_cooperative_groups.h>
#include <cstdio>
#include <cstdint>
namespace cg = cooperative_groups;

#define LAS __attribute__((address_space(3)))
typedef unsigned short bf16_t;
typedef short bf16x8 __attribute__((ext_vector_type(8)));
typedef short s16x4 __attribute__((ext_vector_type(4)));
typedef float f32x4 __attribute__((ext_vector_type(4)));
typedef float f32x16 __attribute__((ext_vector_type(16)));
typedef unsigned u32x4 __attribute__((ext_vector_type(4)));
typedef unsigned u32x2 __attribute__((ext_vector_type(2)));
typedef float f32x2_t __attribute__((ext_vector_type(2)));
typedef __bf16 bf16x2_t __attribute__((ext_vector_type(2)));

__device__ __forceinline__ unsigned pk2(float lo, float hi) { f32x2_t v = {lo, hi}; bf16x2_t b = __builtin_convertvector(v, bf16x2_t); return __builtin_bit_cast(unsigned, b); }
__device__ __forceinline__ float bf_lo(unsigned w) { return __uint_as_float(w << 16); }
__device__ __forceinline__ float bf_hi(unsigned w) { return __uint_as_float(w & 0xffff0000u); }
__device__ __forceinline__ float fast_sigmoid(float x) { return __builtin_amdgcn_rcpf(1.0f + __builtin_amdgcn_exp2f(-1.4426950408889634f * x)); }
__device__ __forceinline__ float wave_sum(float v) {
#pragma unroll
    for (int o = 1; o < 64; o <<= 1) v += __shfl_xor(v, o);
    return v;
}
__device__ __forceinline__ float wave_max(float v) {
#pragma unroll
    for (int o = 1; o < 64; o <<= 1) v = fmaxf(v, __shfl_xor(v, o));
    return v;
}

constexpr int BATCH = 8, SEQ = 4096, DM = 1024, TOK = BATCH * SEQ, FF = 4096, INC = 4096;
constexpr int NG = 32, NP = 64, NCH = 64;
constexpr float EPS = 1e-6f;
constexpr float C2 = 0.125f * 1.4426950408889634f;

constexpr size_t MiB = 1u << 20;
constexpr size_t WS_SMALL = 1 * MiB;
constexpr size_t OFF_LBR = 0, OFF_LBI = 8192, OFF_A64R = 16384, OFF_A64I = 24576;
constexpr size_t OFF_BBF = 32768;
constexpr size_t OFF_CF = 32768 + 131072;
constexpr size_t OFF_RSTD1 = 32768 + 262144;
constexpr size_t OFF_RSS2 = OFF_RSTD1 + 131072;
constexpr size_t WS_W_IN = 2 * MiB, WS_W_MI = 10 * MiB, WS_W_MO = 18 * MiB, WS_W_OUT = 26 * MiB, WS_W_PA = 28 * MiB, WS_W_PS = 29 * MiB, WS_W_GLU = 30 * MiB;
constexpr size_t WS_SEND = 32 * MiB, WS_CARRY = 40 * MiB;
constexpr size_t WS_Q = 64 * MiB, WS_K = 96 * MiB, WS_V = 128 * MiB, WS_U = 160 * MiB, WS_G = 192 * MiB, WS_XB = 320 * MiB;
constexpr size_t WS_MG = 128 * MiB;
constexpr size_t WS_H = 128 * MiB;
constexpr size_t WS_X1B = WS_Q;
constexpr size_t WS_AO = 384 * MiB;
constexpr size_t WS_END = 448 * MiB;

#ifndef PHMASK
#define PHMASK 0xFFFF
#endif
constexpr int LDS_BYTES = 147456;
constexpr int RING_BYTES = 131072;

namespace pg8 {
constexpr int BM = 256, BK = 64, HALF = 128, HTB = HALF * BK * 2, NXCD = 8, WGM = 8;
__host__ __device__ __forceinline__ int lds_byte(int r, int c) { const int st = (r >> 4) * 2 + (c >> 5), rr = r & 15, cc = c & 31, ob = rr * 64 + cc * 2; return st * 1024 + (ob ^ (((ob >> 9) & 1) << 5)); }
__host__ __device__ __forceinline__ void stage_rc(int b, int& R, int& C) { const int st = b / 1024, sb = b % 1024, swz = sb ^ (((sb >> 9) & 1) << 5); R = (st >> 1) * 16 + swz / 64; C = (st & 1) * 32 + (swz % 64) / 2; }
__host__ __device__ __forceinline__ int perm32(int rho) { const int n = rho >> 4, i = rho & 15; return 8 * (i >> 2) + 4 * n + (i & 3); }
__device__ __forceinline__ void pg8_glds16(const void* sbase, unsigned voff, unsigned lds_dst) { unsigned keep;
    asm volatile("s_mov_b32 %0, m0\n\ts_mov_b32 m0, %3\n\ts_nop 0\n\tglobal_load_lds_dwordx4 %1, %2\n\ts_mov_b32 m0, %0" : "=&s"(keep) : "v"(voff), "s"(sbase), "s"(lds_dst) : "memory"); }
struct Unit { int pm, pn; };
struct Gemm { const bf16_t* A; const bf16_t* Bt; int M, N, K; };
struct StaticOrder {
    int nM, nN, nwg, G, c;
    __device__ void init(int M, int N, int G_, int c_) { nM = M / BM; nN = N / BM; nwg = nM * nN; G = G_; c = c_; }
    __device__ bool next(int i, Unit& u) const {
        const long L = (long)i * G + c; if (L >= nwg) return false;
        int wgid = (int)L; { const int q = nwg / NXCD, r = nwg % NXCD, xcd = wgid % NXCD, off = wgid / NXCD; wgid = (xcd < r ? xcd * (q + 1) : r * (q + 1) + (xcd - r) * q) + off; }
        const int nig = WGM * nN, gid = wgid / nig, fm = gid * WGM, gsz = (nM - fm) < WGM ? (nM - fm) : WGM;
        u.pm = fm + ((wgid % nig) % gsz); u.pn = (wgid % nig) / gsz; return true;
    }
};

template <class Epi, class Sched, bool MID = false>
__device__ __forceinline__ void gemm_phase(LAS unsigned char* lds, const Gemm g, const Sched& S, const Epi& E) {
    int tid = threadIdx.x; asm volatile("" : "+v"(tid));
    const int wid = __builtin_amdgcn_readfirstlane(tid >> 6), lane = tid & 63, wr = wid >> 2, wc = wid & 3, fr = lane & 15, fq = lane >> 4;
    const int K = g.K, nt = K / BK;
    unsigned voffA[2], voffB[2];
#pragma unroll
    for (int i = 0; i < 2; ++i) { int R, C; stage_rc(tid * 16 + i * 8192, R, C); const int Rb = (R & ~31) + perm32(R & 31);
        voffA[i] = (unsigned)(R * K + C) * 2u; voffB[i] = (unsigned)(Rb * K + C) * 2u; }
    const size_t kstep = (size_t)(BK * 2);
    const size_t hstep = (size_t)HALF * K * 2;
    const size_t tstep = 2 * hstep;
    const unsigned ldsw = (unsigned)wid * 1024u; const unsigned lds0_ = (unsigned)(uintptr_t)lds;
    const int aoff = lds_byte(wr * 64 + fr, fq * 8), boff = lds_byte(wc * 32 + fr, fq * 8);
#define PG8_SA(b, h) (((b) * 2 + (h)) * HTB)
#define PG8_SB(b, h) ((4 + (b) * 2 + (h)) * HTB)
#define PG8_STAGE(bufoff, gbase, voff) do { _Pragma("unroll") for (int _i = 0; _i < 2; ++_i) \
        pg8_glds16((const void*)(gbase), (voff)[_i], (unsigned)__builtin_amdgcn_readfirstlane(lds0_ + (bufoff) + ldsw + _i * 8192)); } while (0)
#define PG8_LDA(dst, b, h) do { _Pragma("unroll") for (int m = 0; m < 4; ++m) _Pragma("unroll") for (int k = 0; k < 2; ++k) dst[m][k] = *(const LAS bf16x8*)(lds + PG8_SA(b, h) + aoff + m * 2048 + k * 1024); } while (0)
#define PG8_LDB(dst, b, h) do { _Pragma("unroll") for (int n = 0; n < 2; ++n) _Pragma("unroll") for (int k = 0; k < 2; ++k) dst[n][k] = *(const LAS bf16x8*)(lds + PG8_SB(b, h) + boff + n * 2048 + k * 1024); } while (0)
#define PG8_MMA(ai, bj, At, Bt) do { __builtin_amdgcn_s_setprio(1); _Pragma("unroll") for (int m = 0; m < 4; ++m) _Pragma("unroll") for (int n = 0; n < 2; ++n) _Pragma("unroll") for (int k = 0; k < 2; ++k) \
        acc[ai][bj][m][n] = __builtin_amdgcn_mfma_f32_16x16x32_bf16(Bt[n][k], At[m][k], acc[ai][bj][m][n], 0, 0, 0); __builtin_amdgcn_s_setprio(0); } while (0)
#define PG8_WAIT_V(n) asm volatile("s_waitcnt vmcnt(" #n ")" ::: "memory")
#define PG8_WAIT_L(n) asm volatile("s_waitcnt lgkmcnt(" #n ")" ::: "memory")
#define PG8_BAR __builtin_amdgcn_s_barrier()
#define PG8_SCHED __builtin_amdgcn_sched_barrier(0)
    Unit cur, nxt; int ui = 0;
    if (!S.next(0, cur)) return;
    f32x4 acc[2][2][4][2];
#pragma unroll
    for (int a = 0; a < 2; ++a)
#pragma unroll
        for (int b = 0; b < 2; ++b)
#pragma unroll
            for (int m = 0; m < 4; ++m)
#pragma unroll
                for (int n = 0; n < 2; ++n) acc[a][b][m][n] = (f32x4){0.f, 0.f, 0.f, 0.f};
    bf16x8 At[4][2], B0[2][2], B1[2][2];
    const char* cA = (const char*)g.A + (size_t)cur.pm * tstep; const char* cB = (const char*)g.Bt + (size_t)cur.pn * tstep;
    PG8_STAGE(PG8_SB(0, 0), cB, voffB); PG8_STAGE(PG8_SB(0, 1), cB + hstep, voffB); PG8_STAGE(PG8_SA(0, 0), cA, voffA); PG8_STAGE(PG8_SA(0, 1), cA + hstep, voffA);
    if (wr == 1) PG8_BAR;
    PG8_WAIT_V(2); PG8_BAR;
    PG8_STAGE(PG8_SB(1, 0), cB + kstep, voffB); PG8_STAGE(PG8_SA(1, 0), cA + kstep, voffA); PG8_STAGE(PG8_SB(1, 1), cB + hstep + kstep, voffB);
    PG8_WAIT_V(6); PG8_BAR;
    for (;;) {
        const bool has_next = S.next(ui + 1, nxt);
        const char* nA = has_next ? (const char*)g.A + (size_t)nxt.pm * tstep : cA; const char* nB = has_next ? (const char*)g.Bt + (size_t)nxt.pn * tstep : cB;
        for (int t = 0; t < nt; t += 2) {
            const bool last = (t == nt - 2);
            const char* a1 = cA + (size_t)(t + 1) * kstep;
            const char* a2 = last ? nA : cA + (size_t)(t + 2) * kstep; const char* b2 = last ? nB : cB + (size_t)(t + 2) * kstep;
            const char* a3 = a2 + kstep; const char* b3 = b2 + kstep;
            if constexpr (MID) { if (t == nt / 2) E.mid(acc, cur, wr, wc, fr, fq); }
            PG8_LDB(B0, 0, 0); PG8_LDB(B1, 0, 1); PG8_SCHED; PG8_LDA(At, 0, 0); PG8_STAGE(PG8_SA(1, 1), a1 + hstep, voffA);
            PG8_WAIT_V(8); PG8_WAIT_L(0); PG8_BAR; PG8_MMA(0, 0, At, B0); PG8_MMA(0, 1, At, B1); PG8_BAR; PG8_SCHED;
            PG8_LDA(At, 0, 1); PG8_STAGE(PG8_SB(0, 0), b2, voffB); PG8_STAGE(PG8_SB(0, 1), b2 + hstep, voffB); PG8_STAGE(PG8_SA(0, 0), a2, voffA);
            PG8_WAIT_V(8); PG8_WAIT_L(0); PG8_BAR; PG8_MMA(1, 0, At, B0); PG8_MMA(1, 1, At, B1); PG8_BAR; PG8_SCHED;
            PG8_LDB(B0, 1, 0); PG8_LDB(B1, 1, 1); PG8_SCHED; PG8_LDA(At, 1, 0); PG8_STAGE(PG8_SA(0, 1), a2 + hstep, voffA);
            PG8_WAIT_V(8); PG8_WAIT_L(0); PG8_BAR; PG8_MMA(0, 0, At, B0); PG8_MMA(0, 1, At, B1); PG8_BAR; PG8_SCHED;
            PG8_LDA(At, 1, 1); PG8_STAGE(PG8_SB(1, 0), b3, voffB); PG8_STAGE(PG8_SB(1, 1), b3 + hstep, voffB); PG8_STAGE(PG8_SA(1, 0), a3, voffA);
            PG8_WAIT_V(8); PG8_WAIT_L(0); PG8_BAR; PG8_MMA(1, 0, At, B0); PG8_MMA(1, 1, At, B1); PG8_BAR; PG8_SCHED;
        }
        if (wr == 0) PG8_BAR;
        E(acc, cur, wr, wc, fr, fq);
        if (!has_next) break;
#pragma unroll
        for (int a = 0; a < 2; ++a)
#pragma unroll
            for (int b = 0; b < 2; ++b)
#pragma unroll
                for (int m = 0; m < 4; ++m)
#pragma unroll
                    for (int n = 0; n < 2; ++n) acc[a][b][m][n] = (f32x4){0.f, 0.f, 0.f, 0.f};
        cur = nxt; cA = nA; cB = nB; ++ui;
        if (wr == 1) PG8_BAR;
    }
    PG8_WAIT_V(0);
    PG8_BAR;
#undef PG8_SA
#undef PG8_SB
#undef PG8_STAGE
#undef PG8_LDA
#undef PG8_LDB
#undef PG8_MMA
#undef PG8_WAIT_V
#undef PG8_WAIT_L
#undef PG8_BAR
#undef PG8_SCHED
}
}

__device__ __forceinline__ int col_nat(int bj, int wc, int fq) { return 128 * bj + 32 * wc + 8 * fq; }
__device__ __forceinline__ int col_inp(int bj, int wc, int fq) { return 64 * wc + 16 * fq + 8 * bj; }

struct EpiIn {
    bf16_t *Q, *K, *V, *U, *G; const float *rstd, *qg, *kg, *bgate;
    __device__ __forceinline__ void operator()(const f32x4 (&acc)[2][2][4][2], const pg8::Unit& u, int wr, int wc, int fr, int fq) const {
        const int pn = u.pn; const int row0 = u.pm * 256 + wr * 64 + fr;
        if (pn < 4) {
            const bool isq = pn < 2; const float* g = isq ? qg : kg; bf16_t* dst = isq ? Q : K; const int colt = (pn & 1) * 256;
            const float post = isq ? C2 : 1.0f;
#pragma unroll
            for (int ai = 0; ai < 2; ++ai)
#pragma unroll
                for (int m = 0; m < 4; ++m) {
                    const int r = row0 + ai * 128 + m * 16; const float rs = rstd[r];
                    f32x4 v[2][2]; float ss = 0.f;
#pragma unroll
                    for (int bj = 0; bj < 2; ++bj)
#pragma unroll
                        for (int n = 0; n < 2; ++n) { v[bj][n] = acc[ai][bj][m][n] * rs; const f32x4 x = v[bj][n]; ss += (x[0] * x[0] + x[1] * x[1]) + (x[2] * x[2] + x[3] * x[3]); }
                    ss += __shfl_xor(ss, 16); ss += __shfl_xor(ss, 32);
                    const float sc = __builtin_amdgcn_rsqf(ss * (1.0f / 64.0f) + EPS) * post;
#pragma unroll
                    for (int bj = 0; bj < 2; ++bj) {
                        const f32x4 g0 = *(const f32x4*)(g + 16 * fq + 8 * bj), g1 = *(const f32x4*)(g + 16 * fq + 8 * bj + 4);
                        const f32x4 a = v[bj][0] * sc * g0, b = v[bj][1] * sc * g1;
                        u32x4 w; w.x = pk2(a[0], a[1]); w.y = pk2(a[2], a[3]); w.z = pk2(b[0], b[1]); w.w = pk2(b[2], b[3]);
                        *(u32x4*)(dst + (size_t)r * 512 + colt + col_inp(bj, wc, fq)) = w;
                    }
                }
        } else if (pn < 8) {
            bf16_t* dst = pn < 6 ? V : U; const int colt = (pn & 1) * 256;
#pragma unroll
            for (int ai = 0; ai < 2; ++ai)
#pragma unroll
                for (int m = 0; m < 4; ++m) {
                    const int r = row0 + ai * 128 + m * 16; const float rs = rstd[r];
#pragma unroll
                    for (int bj = 0; bj < 2; ++bj) {
                        const f32x4 a = acc[ai][bj][m][0] * rs, b = acc[ai][bj][m][1] * rs;
                        u32x4 w; w.x = pk2(a[0], a[1]); w.y = pk2(a[2], a[3]); w.z = pk2(b[0], b[1]); w.w = pk2(b[2], b[3]);
                        *(u32x4*)(dst + (size_t)r * 512 + colt + col_inp(bj, wc, fq)) = w;
                    }
                }
        } else {
            const int colt = (pn - 8) * 256;
            unsigned char* G8 = (unsigned char*)G;
#pragma unroll
            for (int ai = 0; ai < 2; ++ai)
#pragma unroll
                for (int m = 0; m < 4; ++m) {
                    const int r = row0 + ai * 128 + m * 16; const float rs = rstd[r];
                    u32x4 w;
#pragma unroll
                    for (int bj = 0; bj < 2; ++bj) {
                        const float* bp = bgate + colt + col_inp(bj, wc, fq);
                        const f32x4 a = acc[ai][bj][m][0] * rs + *(const f32x4*)bp, b = acc[ai][bj][m][1] * rs + *(const f32x4*)(bp + 4);
                        unsigned lo = 0u, hi = 0u;
#pragma unroll
                        for (int e = 0; e < 4; ++e) {
                            const unsigned qa = (unsigned)fminf(fmaxf(fast_sigmoid(a[e]) * 255.0f + 0.5f, 1.0f), 255.0f);
                            const unsigned qb = (unsigned)fminf(fmaxf(fast_sigmoid(b[e]) * 255.0f + 0.5f, 1.0f), 255.0f);
                            lo |= qa << (8 * e); hi |= qb << (8 * e);
                        }
                        if (bj == 0) { w.x = lo; w.y = hi; } else { w.z = lo; w.w = hi; }
                    }
                    __builtin_nontemporal_store(w, (u32x4*)(G8 + (size_t)r * 2048 + colt + col_inp(0, wc, fq)));
                }
        }
    }
};

struct EpiGlu {
    const bf16_t* Z; bf16_t* S; const float* bglu;
    __device__ __forceinline__ void operator()(const f32x4 (&acc)[2][2][4][2], const pg8::Unit& u, int wr, int wc, int fr, int fq) const {
        const int row0 = u.pm * 256 + wr * 64 + fr; const int colt = u.pn * 256;
#pragma unroll
        for (int bj = 0; bj < 2; ++bj) {
            const int c = colt + col_nat(bj, wc, fq);
            const f32x4 b0 = *(const f32x4*)(bglu + c), b1 = *(const f32x4*)(bglu + c + 4);
#pragma unroll
            for (int ai = 0; ai < 2; ++ai)
#pragma unroll
                for (int m = 0; m < 4; ++m) {
                    const int r = row0 + ai * 128 + m * 16;
                    const u32x4 z = *(const u32x4*)(Z + (size_t)r * 512 + c);
                    const f32x4 a = acc[ai][bj][m][0] + b0, b = acc[ai][bj][m][1] + b1;
                    u32x4 w;
                    w.x = pk2(bf_lo(z.x) * fast_sigmoid(a[0]), bf_hi(z.x) * fast_sigmoid(a[1]));
                    w.y = pk2(bf_lo(z.y) * fast_sigmoid(a[2]), bf_hi(z.y) * fast_sigmoid(a[3]));
                    w.z = pk2(bf_lo(z.z) * fast_sigmoid(b[0]), bf_hi(z.z) * fast_sigmoid(b[1]));
                    w.w = pk2(bf_lo(z.w) * fast_sigmoid(b[2]), bf_hi(z.w) * fast_sigmoid(b[3]));
                    *(u32x4*)(S + (size_t)r * 1024 + 512 + c) = w;
                }
        }
    }
};

struct EpiMergeH {
    const unsigned char* G; bf16_t* Mg;
    __device__ __forceinline__ void mid(f32x4 (&acc)[2][2][4][2], const pg8::Unit& u, int wr, int wc, int fr, int fq) const {
        asm volatile("" : "+v"(fr), "+v"(fq));
        const int row0 = u.pm * 256 + wr * 64 + fr; const int colt = u.pn * 256;
#pragma unroll
        for (int ai = 0; ai < 2; ++ai)
#pragma unroll
            for (int m = 0; m < 4; ++m) {
                const int r = row0 + ai * 128 + m * 16;
#pragma unroll
                for (int bj = 0; bj < 2; ++bj) {
                    const int c = colt + col_nat(bj, wc, fq);
                    const u32x2 ga = *(const u32x2*)(G + (size_t)r * 2048 + c), gs = *(const u32x2*)(G + (size_t)r * 2048 + 1024 + c);
                    f32x4 a = acc[ai][bj][m][0], b = acc[ai][bj][m][1];
#pragma unroll
                    for (int e = 0; e < 4; ++e) {
                        a[e] *= (float)((ga.x >> (8 * e)) & 0xffu) * __builtin_amdgcn_rcpf((float)((gs.x >> (8 * e)) & 0xffu));
                        b[e] *= (float)((ga.y >> (8 * e)) & 0xffu) * __builtin_amdgcn_rcpf((float)((gs.y >> (8 * e)) & 0xffu));
                    }
                    acc[ai][bj][m][0] = a; acc[ai][bj][m][1] = b;
                }
                if (m & 1) asm volatile("" ::: "memory");
            }
    }
    __device__ __forceinline__ void operator()(const f32x4 (&acc)[2][2][4][2], const pg8::Unit& u, int wr, int wc, int fr, int fq) const {
        const int row0 = u.pm * 256 + wr * 64 + fr; const int colt = u.pn * 256;
#pragma unroll
        for (int ai = 0; ai < 2; ++ai)
#pragma unroll
            for (int m = 0; m < 4; ++m) {
                const int r = row0 + ai * 128 + m * 16;
#pragma unroll
                for (int bj = 0; bj < 2; ++bj) {
                    const int c = colt + col_nat(bj, wc, fq);
                    const u32x2 gs = *(const u32x2*)(G + (size_t)r * 2048 + 1024 + c);
                    const f32x4 a = acc[ai][bj][m][0], b = acc[ai][bj][m][1];
                    float o[8];
#pragma unroll
                    for (int e = 0; e < 4; ++e) { o[e] = a[e] * ((float)((gs.x >> (8 * e)) & 0xffu) * (1.0f / 255.0f)); o[4 + e] = b[e] * ((float)((gs.y >> (8 * e)) & 0xffu) * (1.0f / 255.0f)); }
                    u32x4 w; w.x = pk2(o[0], o[1]); w.y = pk2(o[2], o[3]); w.z = pk2(o[4], o[5]); w.w = pk2(o[6], o[7]);
                    *(u32x4*)(Mg + (size_t)r * 1024 + c) = w;
                }
            }
    }
};

struct EpiOut {
    const bf16_t* X; bf16_t* X1B; float* rss;
    __device__ __forceinline__ void operator()(const f32x4 (&acc)[2][2][4][2], const pg8::Unit& u, int wr, int wc, int fr, int fq) const {
        const int row0 = u.pm * 256 + wr * 64 + fr; const int colt = u.pn * 256;
#pragma unroll
        for (int ai = 0; ai < 2; ++ai)
#pragma unroll
            for (int m = 0; m < 4; ++m) {
                const int r = row0 + ai * 128 + m * 16; float ss = 0.f;
#pragma unroll
                for (int bj = 0; bj < 2; ++bj) {
                    const int c = colt + col_nat(bj, wc, fq);
                    const u32x4 xv = *(const u32x4*)(X + (size_t)r * 1024 + c);
                    const f32x4 a0 = acc[ai][bj][m][0], a1 = acc[ai][bj][m][1];
                    f32x4 a, b;
                    a[0] = bf_lo(xv.x) + a0[0]; a[1] = bf_hi(xv.x) + a0[1]; a[2] = bf_lo(xv.y) + a0[2]; a[3] = bf_hi(xv.y) + a0[3];
                    b[0] = bf_lo(xv.z) + a1[0]; b[1] = bf_hi(xv.z) + a1[1]; b[2] = bf_lo(xv.w) + a1[2]; b[3] = bf_hi(xv.w) + a1[3];
                    ss += (a[0] * a[0] + a[1] * a[1]) + (a[2] * a[2] + a[3] * a[3]) + (b[0] * b[0] + b[1] * b[1]) + (b[2] * b[2] + b[3] * b[3]);
                    u32x4 w; w.x = pk2(a[0], a[1]); w.y = pk2(a[2], a[3]); w.z = pk2(b[0], b[1]); w.w = pk2(b[2], b[3]);
                    *(u32x4*)(X1B + (size_t)r * 1024 + c) = w;
                }
                ss += __shfl_xor(ss, 16); ss += __shfl_xor(ss, 32);
                if (fq == 0) atomicAdd(rss + r, ss);
            }
    }
};

struct EpiMlpIn {
    const float* rss; bf16_t* H;
    __device__ __forceinline__ void operator()(const f32x4 (&acc)[2][2][4][2], const pg8::Unit& u, int wr, int wc, int fr, int fq) const {
        const int row0 = u.pm * 256 + wr * 64 + fr; const int colt = u.pn * 256;
#pragma unroll
        for (int ai = 0; ai < 2; ++ai)
#pragma unroll
            for (int m = 0; m < 4; ++m) {
                const int r = row0 + ai * 128 + m * 16; const float rs = __builtin_amdgcn_rsqf(rss[r] * (1.0f / 1024.0f) + EPS);
#pragma unroll
                for (int bj = 0; bj < 2; ++bj) {
                    f32x4 a = acc[ai][bj][m][0] * rs, b = acc[ai][bj][m][1] * rs;
#pragma unroll
                    for (int e = 0; e < 4; ++e) { a[e] = fmaxf(a[e], 0.f); a[e] *= a[e]; b[e] = fmaxf(b[e], 0.f); b[e] *= b[e]; }
                    u32x4 w; w.x = pk2(a[0], a[1]); w.y = pk2(a[2], a[3]); w.z = pk2(b[0], b[1]); w.w = pk2(b[2], b[3]);
                    *(u32x4*)(H + (size_t)r * 4096 + colt + col_nat(bj, wc, fq)) = w;
                }
            }
    }
};

struct EpiMlpOut {
    const bf16_t* X1B; float* O;
    __device__ __forceinline__ void operator()(const f32x4 (&acc)[2][2][4][2], const pg8::Unit& u, int wr, int wc, int fr, int fq) const {
        const int row0 = u.pm * 256 + wr * 64 + fr; const int colt = u.pn * 256;
#pragma unroll
        for (int ai = 0; ai < 2; ++ai)
#pragma unroll
            for (int m = 0; m < 4; ++m) {
                const int r = row0 + ai * 128 + m * 16;
#pragma unroll
                for (int bj = 0; bj < 2; ++bj) {
                    const int c = colt + col_nat(bj, wc, fq);
                    const u32x4 xv = *(const u32x4*)(X1B + (size_t)r * 1024 + c);
                    const f32x4 a0 = acc[ai][bj][m][0], a1 = acc[ai][bj][m][1];
                    f32x4 a, b;
                    a[0] = bf_lo(xv.x) + a0[0]; a[1] = bf_hi(xv.x) + a0[1]; a[2] = bf_lo(xv.y) + a0[2]; a[3] = bf_hi(xv.y) + a0[3];
                    b[0] = bf_lo(xv.z) + a1[0]; b[1] = bf_hi(xv.z) + a1[1]; b[2] = bf_lo(xv.w) + a1[2]; b[3] = bf_hi(xv.w) + a1[3];
                    float* op = O + (size_t)r * 1024 + c;
                    __builtin_nontemporal_store(a, (f32x4*)op); __builtin_nontemporal_store(b, (f32x4*)(op + 4));
                }
            }
    }
};

namespace att {
constexpr int KOFF = 0, VOFF = 49152, TILEB = 16384;
__device__ __forceinline__ unsigned off_b(unsigned row, unsigned ch) { return 256u * row + 16u * (ch ^ (((row & 3u) << 2) | ((row >> 2) & 3u))); }
__device__ __forceinline__ int crow(int r, int hi) { return (r & 3) + 8 * (r >> 2) + 4 * hi; }
__device__ __forceinline__ s16x4 vtr(const LAS unsigned char* p) { return __builtin_bit_cast(s16x4, __builtin_amdgcn_ds_read_tr16_b64_v4i16((LAS s16x4*)p)); }

__device__ __forceinline__ void glds16(const void* gsrc, unsigned lds_dst) { unsigned keep;
    asm volatile("s_mov_b32 %0, m0\n\ts_mov_b32 m0, %2\n\ts_nop 0\n\tglobal_load_lds_dwordx4 %1, off\n\ts_mov_b32 m0, %0" : "=&s"(keep) : "v"(gsrc), "s"(lds_dst) : "memory"); }
__device__ __forceinline__ void scores_exp(const LAS unsigned char* Kb, const bf16x8 (&q)[4], const unsigned (&ka)[4], float negM, f32x16& sA, f32x16& sB) {
#pragma unroll
    for (int r = 0; r < 16; ++r) { sA[r] = 0.f; sB[r] = 0.f; }
#pragma unroll
    for (int s = 0; s < 4; ++s) {
        const bf16x8 kA = *(const LAS bf16x8*)(Kb + ka[s]);
        const bf16x8 kB = *(const LAS bf16x8*)(Kb + ka[s] + 8192);
        sA = __builtin_amdgcn_mfma_f32_32x32x16_bf16(kA, q[s], sA, 0, 0, 0);
        sB = __builtin_amdgcn_mfma_f32_32x32x16_bf16(kB, q[s], sB, 0, 0, 0);
    }
#pragma unroll
    for (int r = 0; r < 16; ++r) { sA[r] = __builtin_amdgcn_exp2f(sA[r]); sB[r] = __builtin_amdgcn_exp2f(sB[r]); }
}
__device__ __forceinline__ float sum16(const f32x16& a, const f32x16& b) {
    float s0 = a[0] + b[0], s1 = a[1] + b[1], s2 = a[2] + b[2], s3 = a[3] + b[3];
#pragma unroll
    for (int r = 4; r < 16; r += 4) { s0 += a[r] + b[r]; s1 += a[r + 1] + b[r + 1]; s2 += a[r + 2] + b[r + 2]; s3 += a[r + 3] + b[r + 3]; }
    return (s0 + s1) + (s2 + s3);
}

__device__ __forceinline__ void attn_unit(int b, int h, int qb, const bf16_t* Q, const bf16_t* K, const bf16_t* V, bf16_t* O, LAS unsigned char* lds,
                                          float lam, float negM, const float* subg) {
    int tid = threadIdx.x; asm volatile("" : "+v"(tid));
    const int lane = tid & 63, r32 = lane & 31, hi = lane >> 5; const int wid = __builtin_amdgcn_readfirstlane(tid >> 6);
    const size_t rowbase = (size_t)b * SEQ; const int q0 = qb * 256;
    const int ntiles = 4 * qb + 4, mytiles = 4 * qb + (wid >> 1) + 1;
    unsigned goff[2];
#pragma unroll
    for (int i = 0; i < 2; ++i) { const unsigned row = 8 * wid + 4 * i + (lane >> 4), cp = lane & 15, ch = cp ^ (((row & 3u) << 2) | ((row >> 2) & 3u));
        goff[i] = (row * 512 + h * 128 + ch * 8) * 2u; }
    const char* Kh = (const char*)(K + rowbase * 512); const char* Vh = (const char*)(V + rowbase * 512);
    const unsigned lds0 = (unsigned)(uintptr_t)lds;
#define ATT_DMA_K(t, slot) do { const size_t tb_ = (size_t)(t) * 64 * 512 * 2; _Pragma("unroll") for (int i_ = 0; i_ < 2; ++i_) \
        glds16(Kh + tb_ + goff[i_], (unsigned)__builtin_amdgcn_readfirstlane(lds0 + KOFF + (slot) * TILEB + (8 * wid + 4 * i_) * 256)); } while (0)
#define ATT_DMA_V(t, slot) do { const size_t tb_ = (size_t)(t) * 64 * 512 * 2; _Pragma("unroll") for (int i_ = 0; i_ < 2; ++i_) \
        glds16(Vh + tb_ + goff[i_], (unsigned)__builtin_amdgcn_readfirstlane(lds0 + VOFF + (slot) * TILEB + (8 * wid + 4 * i_) * 256)); } while (0)
    const bf16_t* Qw = Q + (rowbase + q0 + wid * 32 + r32) * 512 + h * 128;
    bf16x8 q1[4], q2[4];
#pragma unroll
    for (int s = 0; s < 4; ++s) { q1[s] = *(const bf16x8*)(Qw + 16 * s + 8 * hi); q2[s] = *(const bf16x8*)(Qw + 64 + 16 * s + 8 * hi); }
    unsigned ka1[4], ka2[4];
#pragma unroll
    for (int s = 0; s < 4; ++s) { ka1[s] = off_b(r32, 2 * s + hi); ka2[s] = off_b(r32, 8 + 2 * s + hi); }
    asm volatile("s_waitcnt vmcnt(0)" : "+v"(q1[0]), "+v"(q1[1]), "+v"(q1[2]), "+v"(q1[3]), "+v"(q2[0]), "+v"(q2[1]), "+v"(q2[2]), "+v"(q2[3]) :: "memory");
    float l1 = 0.f, l2 = 0.f;
    ATT_DMA_K(0, 0); ATT_DMA_K(1, 1);
    {
        int slot = 0, slot2 = 2;
        for (int t = 0; t < ntiles; ++t) {
            if (t + 1 < ntiles) asm volatile("s_waitcnt vmcnt(2)" ::: "memory"); else asm volatile("s_waitcnt vmcnt(0)" ::: "memory");
            __builtin_amdgcn_s_barrier();
            if (t + 2 < ntiles) ATT_DMA_K(t + 2, slot2);
            if (t < mytiles) {
                const LAS unsigned char* Kb = lds + KOFF + slot * TILEB;
                f32x16 sA, sB;
                scores_exp(Kb, q1, ka1, negM, sA, sB); l1 += sum16(sA, sB);
                scores_exp(Kb, q2, ka2, negM, sA, sB); l2 += sum16(sA, sB);
            }
            slot = (slot == 2) ? 0 : slot + 1; slot2 = (slot2 == 2) ? 0 : slot2 + 1;
        }
    }
    l1 += __shfl_xor(l1, 32); l2 += __shfl_xor(l2, 32);
    const float i1 = __builtin_amdgcn_rcpf(l1), i2 = lam * __builtin_amdgcn_rcpf(l2);
    asm volatile("s_waitcnt lgkmcnt(0)" ::: "memory");
    __builtin_amdgcn_s_barrier();
    f32x16 o[4];
#pragma unroll
    for (int c = 0; c < 4; ++c)
#pragma unroll
        for (int r = 0; r < 16; ++r) o[c][r] = 0.f;
    const unsigned blk = (lane >> 4) & 1, qq = (lane & 15) >> 2, pp = lane & 3;
    unsigned trb[2];
#pragma unroll
    for (int t = 0; t < 2; ++t) trb[t] = 256u * (8 * t + 4 * hi + qq) + 16u * ((2 * blk + (pp >> 1)) ^ (2 * t + hi)) + 8u * (pp & 1);
    ATT_DMA_K(0, 0); ATT_DMA_V(0, 0); ATT_DMA_K(1, 1); ATT_DMA_V(1, 1);
    {
        int slot = 0, slot2 = 2;
        for (int t = 0; t < ntiles; ++t) {
            if (t + 1 < ntiles) asm volatile("s_waitcnt vmcnt(4)" ::: "memory"); else asm volatile("s_waitcnt vmcnt(0)" ::: "memory");
            __builtin_amdgcn_s_barrier();
            if (t + 2 < ntiles) { ATT_DMA_K(t + 2, slot2); ATT_DMA_V(t + 2, slot2); }
            if (t < mytiles) {
                const LAS unsigned char* Kb = lds + KOFF + slot * TILEB; const LAS unsigned char* Vb = lds + VOFF + slot * TILEB;
                f32x16 pA, pB, rA, rB;
                scores_exp(Kb, q1, ka1, negM, pA, pB);
                scores_exp(Kb, q2, ka2, negM, rA, rB);
#pragma unroll
                for (int r = 0; r < 16; ++r) { pA[r] = pA[r] * i1 - rA[r] * i2; pB[r] = pB[r] * i1 - rB[r] * i2; }
                bf16x8 pa[4];
#pragma unroll
                for (int h2 = 0; h2 < 2; ++h2) {
                    u32x4 wa, wb;
                    wa.x = pk2(pA[8 * h2 + 0], pA[8 * h2 + 1]); wa.y = pk2(pA[8 * h2 + 2], pA[8 * h2 + 3]); wa.z = pk2(pA[8 * h2 + 4], pA[8 * h2 + 5]); wa.w = pk2(pA[8 * h2 + 6], pA[8 * h2 + 7]);
                    wb.x = pk2(pB[8 * h2 + 0], pB[8 * h2 + 1]); wb.y = pk2(pB[8 * h2 + 2], pB[8 * h2 + 3]); wb.z = pk2(pB[8 * h2 + 4], pB[8 * h2 + 5]); wb.w = pk2(pB[8 * h2 + 6], pB[8 * h2 + 7]);
                    pa[h2] = __builtin_bit_cast(bf16x8, wa); pa[2 + h2] = __builtin_bit_cast(bf16x8, wb);
                }
#pragma unroll
                for (int c = 0; c < 4; ++c) {
                    const unsigned cx = 64u * ((unsigned)c ^ qq);
#pragma unroll
                    for (int ks = 0; ks < 4; ++ks) {
                        const s16x4 lo = vtr(Vb + trb[0] + cx + ks * 4096), hi4 = vtr(Vb + trb[1] + cx + ks * 4096);
                        const bf16x8 vf = {lo[0], lo[1], lo[2], lo[3], hi4[0], hi4[1], hi4[2], hi4[3]};
                        o[c] = __builtin_amdgcn_mfma_f32_32x32x16_bf16(pa[ks], vf, o[c], 0, 0, 0);
                    }
                }
            }
            slot = (slot == 2) ? 0 : slot + 1; slot2 = (slot2 == 2) ? 0 : slot2 + 1;
        }
    }
#undef ATT_DMA_K
#undef ATT_DMA_V
    float sg[4];
#pragma unroll
    for (int c = 0; c < 4; ++c) sg[c] = subg[32 * c + r32] * 0.8f;
    bf16_t* Ow = O + (rowbase + q0 + wid * 32) * 1024 + h * 128 + r32;
#pragma unroll
    for (int r = 0; r < 16; ++r) {
        const int qr = crow(r, hi);
        float ss = 0.f;
#pragma unroll
        for (int c = 0; c < 4; ++c) ss += o[c][r] * o[c][r];
        ss += __shfl_xor(ss, 1); ss += __shfl_xor(ss, 2); ss += __shfl_xor(ss, 4); ss += __shfl_xor(ss, 8); ss += __shfl_xor(ss, 16);
        const float sc = __builtin_amdgcn_rsqf(ss * (1.0f / 128.0f) + EPS);
#pragma unroll
        for (int c = 0; c < 4; ++c) { const unsigned w = pk2(o[c][r] * sc * sg[c], 0.f); Ow[(size_t)qr * 1024 + 32 * c] = (bf16_t)(w & 0xffffu); }
    }
    asm volatile("s_waitcnt vmcnt(0) lgkmcnt(0)" ::: "memory");
    __builtin_amdgcn_s_barrier();
}
}

constexpr int SSM_XP = 68;
constexpr int SSM_LDP = 132;
constexpr int SSM_WAVE_BYTES = 17408;
template <bool FULL>
__device__ __forceinline__ void ssm_task(int b, int g, int c, unsigned char* ws, const float* Dvec, LAS float* scr, int lane) {
    const float* LBR = (const float*)(ws + WS_SMALL + OFF_LBR); const float* LBI = (const float*)(ws + WS_SMALL + OFF_LBI);
    const bf16x8* BBF = (const bf16x8*)(ws + WS_SMALL + OFF_BBF); const bf16x8* CF = (const bf16x8*)(ws + WS_SMALL + OFF_CF);
    bf16_t* U = (bf16_t*)(ws + WS_U);
    const int r32 = lane & 31, hi = lane >> 5;
    const float lbr = LBR[g * 64 + lane], lbi = LBI[g * 64 + lane];
    const size_t sidx = (((size_t)b * NG + g) * NCH + c) * 128;
    float xr = 0.f, xi = 0.f;
    if (FULL) { const float* CARRY = (const float*)(ws + WS_CARRY); xr = CARRY[sidx + lane]; xi = CARRY[sidx + 64 + lane]; }
    bf16x8 bfr[4];
#pragma unroll
    for (int cb = 0; cb < 4; ++cb) bfr[cb] = BBF[(g * 4 + cb) * 64 + lane];
    bf16x8 cfr[4];
    float dn = 0.f;
    if (FULL) {
#pragma unroll
        for (int s = 0; s < 4; ++s) cfr[s] = CF[(g * 4 + s) * 64 + lane];
        dn = Dvec[16 * g + (lane & 15)];
    }
    const size_t row0 = (size_t)b * SEQ + (size_t)c * 64;
#pragma unroll 1
    for (int jb = 0; jb < 2; ++jb) {
        const bf16x8 ua = *(const bf16x8*)(U + (row0 + 32 * jb + r32) * 512 + 16 * g + 8 * hi);
        bf16_t upre[2][4];
        if (FULL) {
#pragma unroll
            for (int jbb = 0; jbb < 2; ++jbb)
#pragma unroll
                for (int e = 0; e < 4; ++e) upre[jbb][e] = U[(row0 + 32 * jb + 16 * jbb + 4 * (lane >> 4) + e) * 512 + 16 * g + (lane & 15)];
        }
        f32x16 zr0, zr1, zi0, zi1;
#pragma unroll
        for (int r = 0; r < 16; ++r) { zr0[r] = 0.f; zr1[r] = 0.f; zi0[r] = 0.f; zi1[r] = 0.f; }
        zr0 = __builtin_amdgcn_mfma_f32_32x32x16_bf16(ua, bfr[0], zr0, 0, 0, 0);
        zr1 = __builtin_amdgcn_mfma_f32_32x32x16_bf16(ua, bfr[1], zr1, 0, 0, 0);
        zi0 = __builtin_amdgcn_mfma_f32_32x32x16_bf16(ua, bfr[2], zi0, 0, 0, 0);
        zi1 = __builtin_amdgcn_mfma_f32_32x32x16_bf16(ua, bfr[3], zi1, 0, 0, 0);
#pragma unroll
        for (int r = 0; r < 16; ++r) {
            const auto pr = __builtin_amdgcn_permlane32_swap(__float_as_uint(zr0[r]), __float_as_uint(zr1[r]), false, false);
            zr0[r] = __uint_as_float(pr[0]); zr1[r] = __uint_as_float(pr[1]);
            const auto pi = __builtin_amdgcn_permlane32_swap(__float_as_uint(zi0[r]), __float_as_uint(zi1[r]), false, false);
            zi0[r] = __uint_as_float(pi[0]); zi1[r] = __uint_as_float(pi[1]);
        }
#pragma unroll
        for (int j = 0; j < 32; ++j) {
            const int hh = (j >> 2) & 1, rr = (j & 3) + 4 * (j >> 3);
            const float br = hh ? zr1[rr] : zr0[rr], bi = hh ? zi1[rr] : zi0[rr];
            const float nr = lbr * xr - lbi * xi + br, ni = lbr * xi + lbi * xr + bi;
            xr = nr; xi = ni;
            if (FULL) ((LAS unsigned*)scr)[j * SSM_XP + lane] = pk2(xr, xi);
        }
        if (FULL) {
            asm volatile("s_waitcnt lgkmcnt(0)" ::: "memory");
            __builtin_amdgcn_wave_barrier();
            const int n = lane & 15, kq = lane >> 4;
            float zv[2][4];
#pragma unroll
            for (int jbb = 0; jbb < 2; ++jbb) {
                f32x4 y = {0.f, 0.f, 0.f, 0.f};
#pragma unroll
                for (int s = 0; s < 4; ++s) {
                    const bf16x8 xa = *(const LAS bf16x8*)((const LAS unsigned*)scr + (16 * jbb + n) * SSM_XP + 16 * s + 4 * kq);
                    y = __builtin_amdgcn_mfma_f32_16x16x32_bf16(xa, cfr[s], y, 0, 0, 0);
                }
#pragma unroll
                for (int e = 0; e < 4; ++e) {
                    const float uu = __uint_as_float(((unsigned)upre[jbb][e]) << 16);
                    const float yv = y[e] + dn * uu;
                    const float inner = 0.7978845608028654f * (yv + 0.044715f * yv * yv * yv);
                    zv[jbb][e] = yv * fast_sigmoid(2.0f * inner);
                }
            }
            asm volatile("s_waitcnt lgkmcnt(0)" ::: "memory"); __builtin_amdgcn_wave_barrier();
            {
                LAS unsigned char* sb = (LAS unsigned char*)scr;
#pragma unroll
                for (int jbb = 0; jbb < 2; ++jbb)
#pragma unroll
                    for (int e = 0; e < 4; ++e) *(LAS bf16_t*)(sb + (16 * jbb + 4 * kq + e) * 32 + n * 2) = (bf16_t)(pk2(zv[jbb][e], 0.f) & 0xffffu);
                asm volatile("s_waitcnt lgkmcnt(0)" ::: "memory"); __builtin_amdgcn_wave_barrier();
                const u32x4 zz = *(const LAS u32x4*)(sb + (lane >> 1) * 32 + (lane & 1) * 16);
                *(u32x4*)(U + (row0 + 32 * jb + (lane >> 1)) * 512 + 16 * g + 8 * (lane & 1)) = zz;
            }
            asm volatile("s_waitcnt lgkmcnt(0)" ::: "memory");
            __builtin_amdgcn_wave_barrier();
        }
    }
    if (!FULL) { float* SEND = (float*)(ws + WS_SEND); SEND[sidx + lane] = xr; SEND[sidx + 64 + lane] = xi; }
}

template <bool HASG>
__device__ __forceinline__ void p0_transpose_item(const float* W, int K, int N, bf16_t* WT, bool permw, const float* gk, LAS float* scr, int item, int lane, int ldk = 0, int koff = 0) {
    if (ldk == 0) ldk = K;
    const int nblk = N / 32, kb = item / nblk, nb = item % nblk, k0 = 64 * kb, n0 = 32 * nb;
    float v[32]; float gv[32];
    const float* wp = W + (size_t)(k0 + (lane >> 5)) * N + n0 + (lane & 31);
#pragma unroll
    for (int i = 0; i < 32; ++i) { v[i] = __builtin_nontemporal_load(wp + (size_t)(2 * i) * N); if (HASG) gv[i] = gk[k0 + 2 * i + (lane >> 5)]; }
    asm volatile("" ::: "memory");
#pragma unroll
    for (int i = 0; i < 32; ++i) { const int kk = 2 * i + (lane >> 5); scr[kk * 33 + (lane & 31)] = HASG ? v[i] * gv[i] : v[i]; }
    asm volatile("s_waitcnt lgkmcnt(0)" ::: "memory"); __builtin_amdgcn_wave_barrier();
    int p0 = n0;
    const int c = lane & 7;
#pragma unroll
    for (int j = 0; j < 4; ++j) { const int n = (lane >> 3) + 8 * j; const LAS float* s = scr + (8 * c) * 33 + n;
        u32x4 o; o.x = pk2(s[0 * 33], s[1 * 33]); o.y = pk2(s[2 * 33], s[3 * 33]); o.z = pk2(s[4 * 33], s[5 * 33]); o.w = pk2(s[6 * 33], s[7 * 33]);
        int prow = p0 + n;
        if (permw) { const int lam_ = n0 + n, pn = lam_ >> 8, w = (lam_ >> 6) & 3, f = (lam_ >> 4) & 3, bb = (lam_ >> 3) & 1, jj = lam_ & 7; prow = pn * 256 + bb * 128 + w * 32 + f * 8 + jj; }
        *(u32x4*)(WT + (size_t)prow * ldk + koff + k0 + 8 * c) = o; }
    asm volatile("s_waitcnt lgkmcnt(0)" ::: "memory"); __builtin_amdgcn_wave_barrier();
}

__device__ __forceinline__ void sincos_d(double x, double& s, double& c) {
    const double TWO_PI = 6.283185307179586476925;
    const double k = __builtin_rint(x / TWO_PI); const double r = x - k * TWO_PI; const double r2 = r * r;
    double ts = 1.0, tc = 1.0;
#pragma unroll 1
    for (int n = 16; n >= 1; --n) { ts = 1.0 - ts * r2 / (double)((2 * n) * (2 * n + 1)); tc = 1.0 - tc * r2 / (double)((2 * n - 1) * (2 * n)); }
    s = r * ts; c = tc;
}

#define RLX_AGENT __ATOMIC_RELAXED, __HIP_MEMORY_SCOPE_AGENT
#define XB_TMO      128
#define XB_XCNT(j)  (256  + 64 * (j))
#define XB_XSUB(j)  (1280 + 64 * (j))
#define XB_XGEN(j)  (2304 + 64 * (j))
#define XB_TOP      3328
#define XB_TOPGEN   3392
#define XCD_BAR_WORDS 3456
#define XB_SPIN_CAP (1u << 20)
__device__ __forceinline__ unsigned xb_ld(unsigned* p)              { return __hip_atomic_load(p, __ATOMIC_RELAXED, __HIP_MEMORY_SCOPE_AGENT); }
__device__ __forceinline__ unsigned xb_add(unsigned* p, unsigned v) { return __hip_atomic_fetch_add(p, v, __ATOMIC_RELAXED, __HIP_MEMORY_SCOPE_AGENT); }
__device__ __forceinline__ unsigned xb_xcc_id() { return (unsigned)__builtin_amdgcn_s_getreg((3 << 11) | 20) & 0xFu; }
#define XB_SPIN(cond, bar) do { unsigned _sp = 0; while (cond) { __builtin_amdgcn_s_sleep(1); \
    if ((++_sp & 255u) == 0u) { if (xb_ld(&(bar)[XB_TMO])) break; if (_sp > XB_SPIN_CAP) { atomicAdd(&(bar)[XB_TMO], 1u); break; } } } } while (0)
struct XcdBarrier { unsigned* bar; unsigned x; volatile LAS unsigned* st; };
__device__ __forceinline__ XcdBarrier xcd_barrier_post(unsigned* bar, volatile LAS unsigned* st) {
    XcdBarrier b; b.bar = bar; b.x = xb_xcc_id(); b.st = st;
    if (threadIdx.x == 0) (void)xb_add(&bar[XB_XCNT(b.x)], 1u);
    return b;
}
__device__ __forceinline__ void xcd_barrier_complete(unsigned* bar, unsigned x, unsigned& nloc, unsigned& nx) {
    const unsigned G = gridDim.x * gridDim.y * gridDim.z;
    unsigned sum, cnt, mine, sp = 0u;
    for (;;) {
        sum = 0u; cnt = 0u; mine = 0u;
#pragma unroll
        for (unsigned j = 0; j < 16; ++j) { const unsigned c = xb_ld(&bar[XB_XCNT(j)]); sum += c; cnt += (c > 0u) ? 1u : 0u; mine = (j == x) ? c : mine; }
        if (sum == G) break;
        __builtin_amdgcn_s_sleep(1);
        if ((++sp & 255u) == 0u) { if (xb_ld(&bar[XB_TMO])) break; if (sp > XB_SPIN_CAP) { atomicAdd(&bar[XB_TMO], 1u); break; } }
    }
    nloc = mine > 0u ? mine : 1u; nx = cnt > 0u ? cnt : 1u;
}
__device__ __forceinline__ void xcd_barrier(const XcdBarrier& b) {
    asm volatile("s_waitcnt vmcnt(0)" ::: "memory");
    __syncthreads();
    if (threadIdx.x == 0) {
        unsigned* bar = b.bar;
        __builtin_amdgcn_s_waitcnt(0);
        unsigned nloc = b.st[0], nx = b.st[1];
        if (nloc == 0u) { xcd_barrier_complete(bar, b.x, nloc, nx); b.st[0] = nloc; b.st[1] = nx; }
        const unsigned old = xb_add(&bar[XB_XSUB(b.x)], 1u);
        const unsigned gen = old / nloc;
        if (old + 1u == (gen + 1u) * nloc) {
            __builtin_amdgcn_fence(__ATOMIC_RELEASE, "agent");
            asm volatile("s_waitcnt vmcnt(0)" ::: "memory");
            const unsigned og = xb_add(&bar[XB_TOP], 1u);
            const unsigned tg = og / nx;
            if (og + 1u == (tg + 1u) * nx) xb_add(&bar[XB_TOPGEN], 1u);
            else XB_SPIN(xb_ld(&bar[XB_TOPGEN]) == tg, bar);
            __builtin_amdgcn_fence(__ATOMIC_ACQUIRE, "agent");
            xb_add(&bar[XB_XGEN(b.x)], 1u);
            asm volatile("s_waitcnt vmcnt(0)" ::: "memory");
        } else {
            XB_SPIN(xb_ld(&bar[XB_XGEN(b.x)]) == gen, bar);
            __builtin_amdgcn_fence(__ATOMIC_ACQUIRE, "agent");
            asm volatile("s_waitcnt vmcnt(0)" ::: "memory");
        }
    }
    __syncthreads();
}

struct Params {
    const float *x, *norm_mix_g, *w_in, *b_gate, *q_norm_g, *k_norm_g, *lq1, *lk1, *lq2, *lk2, *subln_g, *a_re, *a_im, *log_dt, *b_re, *b_im, *c_re, *c_im, *ssm_d,
        *w_glu, *b_glu, *w_pa, *w_ps, *w_out, *norm_mlp_g, *w_mi, *w_mo;
    float* out; unsigned char* ws;
};

__global__ void __launch_bounds__(512, 2) mega(Params P) {
    extern __shared__ __attribute__((aligned(16))) unsigned char lds_raw[];
    LAS unsigned char* lds = (LAS unsigned char*)lds_raw;
    cg::grid_group grid = cg::this_grid();
    const int tid = threadIdx.x, lane = tid & 63; const int wid = __builtin_amdgcn_readfirstlane(tid >> 6);
    const int G = gridDim.x, bx = blockIdx.x;
    const int vcu = (G % 8 == 0) ? (bx % 8) * (G / 8) + bx / 8 : bx;
    const int gw = vcu * 8 + wid, NGW = G * 8;
    unsigned char* ws = P.ws;
    volatile LAS unsigned* xst = (volatile LAS unsigned*)(lds + LDS_BYTES - 64);
    if (tid < 16) xst[tid] = 0u;
    __syncthreads();
    XcdBarrier xbar = xcd_barrier_post((unsigned*)ws, xst);
#define Wt_in ((bf16_t*)(ws + WS_W_IN))
#define Wt_mi ((bf16_t*)(ws + WS_W_MI))
#define Wt_mo ((bf16_t*)(ws + WS_W_MO))
#define Wt_out ((bf16_t*)(ws + WS_W_OUT))
#define Wt_pa ((bf16_t*)(ws + WS_W_PA))
#define Wt_ps ((bf16_t*)(ws + WS_W_PS))
#define Wt_glu ((bf16_t*)(ws + WS_W_GLU))
#define QB ((bf16_t*)(ws + WS_Q))
#define KB ((bf16_t*)(ws + WS_K))
#define VB ((bf16_t*)(ws + WS_V))
#define UB ((bf16_t*)(ws + WS_U))
#define GB ((bf16_t*)(ws + WS_G))
#define XB ((bf16_t*)(ws + WS_XB))
#define HB ((bf16_t*)(ws + WS_H))
#define X1B ((bf16_t*)(ws + WS_X1B))
#define AOB ((bf16_t*)(ws + WS_AO))
#define MGB ((bf16_t*)(ws + WS_MG))
#define rstd1 ((float*)(ws + WS_SMALL + OFF_RSTD1))
#define rss2 ((float*)(ws + WS_SMALL + OFF_RSS2))

    {
        LAS float* scr = (LAS float*)(lds + wid * 16384);
        for (int gt = bx * 512 + tid; gt < NG * NP * 16; gt += G * 512) {
            const int gp = gt >> 4, n = gt & 15, g = gp >> 6, p = gp & 63;
            const double dt = exp((double)P.log_dt[g]); const double ar = (double)P.a_re[gp], ai = (double)P.a_im[gp];
            const double mag = exp(ar * dt); double sn, cs; sincos_d(ai * dt, sn, cs);
            const double lr = mag * cs, li = mag * sn; const double den = ar * ar + ai * ai; const double nr = lr - 1.0, ni = li;
            const double fr = (nr * ar + ni * ai) / den, fi = (ni * ar - nr * ai) / den;
            if (n == 0) {
                double pr = lr, pi = li;
#pragma unroll 1
                for (int k = 0; k < 6; ++k) { const double t = pr * pr - pi * pi; pi = 2.0 * pr * pi; pr = t; }
                ((float*)(ws + WS_SMALL + OFF_LBR))[gp] = (float)lr; ((float*)(ws + WS_SMALL + OFF_LBI))[gp] = (float)li;
                ((float*)(ws + WS_SMALL + OFF_A64R))[gp] = (float)pr; ((float*)(ws + WS_SMALL + OFF_A64I))[gp] = (float)pi;
            }
            bf16_t* BBF = (bf16_t*)(ws + WS_SMALL + OFF_BBF);
            const double br = (double)P.b_re[gt], bi = (double)P.b_im[gt];
            const float vre = (float)(fr * br - fi * bi), vim = (float)(fr * bi + fi * br);
            const int hi = n >> 3, e = n & 7, ln = (p & 31) + 32 * hi;
            BBF[(((size_t)g * 4 + (p >> 5)) * 64 + ln) * 8 + e] = (bf16_t)(pk2(vre, 0.f) & 0xffffu);
            BBF[(((size_t)g * 4 + 2 + (p >> 5)) * 64 + ln) * 8 + e] = (bf16_t)(pk2(vim, 0.f) & 0xffffu);
        }
        for (int gt = bx * 512 + tid; gt < NG * 4 * 64 * 8; gt += G * 512) {
            const int e = gt & 7, q = gt >> 3, g = q >> 8, s = (q >> 6) & 3, ln = q & 63, n = ln & 15, kq = ln >> 4;
            bf16_t* CF = (bf16_t*)(ws + WS_SMALL + OFF_CF);
            const int col = 32 * s + 8 * kq + e, pst = col >> 1;
            const float v = (col & 1) ? -P.c_im[((size_t)g * 16 + n) * 64 + pst] : P.c_re[((size_t)g * 16 + n) * 64 + pst];
            CF[gt] = (bf16_t)(pk2(v, 0.f) & 0xffffu);
        }
        constexpr int I_IN = 16 * 128, I_GLU = 8 * 16, I_PA = 8 * 32, I_PS = 8 * 32, I_OUT = 16 * 32, I_MI = 16 * 128, I_MO = 64 * 32;
        constexpr int NITEMS = I_IN + I_GLU + I_PA + I_PS + I_OUT + I_MI + I_MO;
        constexpr int NQUAD = TOK / 4;
        for (int it = gw; it < NITEMS + NQUAD; it += NGW) {
            int r = it;
            if (r < I_IN) { p0_transpose_item<true>(P.w_in, 1024, 4096, Wt_in, true, P.norm_mix_g, scr, r, lane); continue; } r -= I_IN;
            if (r < I_GLU) { p0_transpose_item<false>(P.w_glu, 512, 512, Wt_glu, false, nullptr, scr, r, lane); continue; } r -= I_GLU;
            if (r < I_PA) { p0_transpose_item<false>(P.w_pa, 512, 1024, Wt_pa, false, nullptr, scr, r, lane, 1024, 0); continue; } r -= I_PA;
            if (r < I_PS) { p0_transpose_item<false>(P.w_ps, 512, 1024, Wt_pa, false, nullptr, scr, r, lane, 1024, 512); continue; } r -= I_PS;
            if (r < I_OUT) { p0_transpose_item<false>(P.w_out, 1024, 1024, Wt_out, false, nullptr, scr, r, lane); continue; } r -= I_OUT;
            if (r < I_MI) { p0_transpose_item<true>(P.w_mi, 1024, 4096, Wt_mi, false, P.norm_mlp_g, scr, r, lane); continue; } r -= I_MI;
            if (r < I_MO) { p0_transpose_item<false>(P.w_mo, 4096, 1024, Wt_mo, false, nullptr, scr, r, lane); continue; } r -= I_MO;
            const int m0 = 4 * r;
            f32x4 v[4][4];
#pragma unroll
            for (int q = 0; q < 4; ++q) { const f32x4* xr = (const f32x4*)(P.x + (size_t)(m0 + q) * DM) + lane;
#pragma unroll
                for (int j = 0; j < 4; ++j) v[q][j] = __builtin_nontemporal_load(xr + 64 * j); }
            asm volatile("" ::: "memory");
#pragma unroll
            for (int q = 0; q < 4; ++q) {
                float s = 0.f;
#pragma unroll
                for (int j = 0; j < 4; ++j) s += (v[q][j][0] * v[q][j][0] + v[q][j][1] * v[q][j][1]) + (v[q][j][2] * v[q][j][2] + v[q][j][3] * v[q][j][3]);
                s = wave_sum(s);
                u32x2* o8 = (u32x2*)(XB + (size_t)(m0 + q) * DM) + lane;
#pragma unroll
                for (int j = 0; j < 4; ++j) { u32x2 w; w.x = pk2(v[q][j][0], v[q][j][1]); w.y = pk2(v[q][j][2], v[q][j][3]); o8[64 * j] = w; }
                if (lane == 0) { rstd1[m0 + q] = 1.0f / sqrtf(s * (1.0f / 1024.0f) + EPS); rss2[m0 + q] = 0.f; }
            }
        }
    }
    if (__builtin_expect(P.out == nullptr, 0)) grid.sync();
    xcd_barrier(xbar);

    if (PHMASK & 2) {
        pg8::Gemm g{XB, Wt_in, TOK, INC, DM}; pg8::StaticOrder S; S.init(TOK, INC, G, bx);
        EpiIn E{QB, KB, VB, UB, GB, rstd1, P.q_norm_g, P.k_norm_g, P.b_gate};
        pg8::gemm_phase<EpiIn, pg8::StaticOrder>(lds, g, S, E);
    }
    xcd_barrier(xbar);

    if (PHMASK & 4) {
        LAS float* scr = (LAS float*)(lds + wid * SSM_WAVE_BYTES);
        for (int it = gw; it < BATCH * NG * NCH; it += NGW) { const int c = it & 63, g = (it >> 6) & 31, b = it >> 11; ssm_task<false>(b, g, c, ws, P.ssm_d, scr, lane); }
        __syncthreads();
        const float d1 = wave_sum(P.lq1[lane] * P.lk1[lane]), d2 = wave_sum(P.lq2[lane] * P.lk2[lane]);
        const float lam = __builtin_amdgcn_exp2f(d1 * 1.4426950408889634f) - __builtin_amdgcn_exp2f(d2 * 1.4426950408889634f) + 0.2f;
        const float gqm = wave_max(fabsf(P.q_norm_g[lane])), gkm = wave_max(fabsf(P.k_norm_g[lane]));
        const float negM = 0.0f; (void)gqm; (void)gkm;
        for (int i = 0;; ++i) {
            const int idx = vcu + i * G; if (idx >= 512) break;
            const int pr = idx & 255, second = idx >> 8, bh = pr >> 3, s = pr & 7, qb = second ? 15 - s : s;
            att::attn_unit(bh >> 2, bh & 3, qb, QB, KB, VB, AOB, lds, lam, negM, P.subln_g);
        }
    }
    xcd_barrier(xbar);

    if ((PHMASK & 8) && wid == 0) {
        const float* SEND = (const float*)(ws + WS_SEND); float* CARRY = (float*)(ws + WS_CARRY);
        for (int bg = bx; bg < BATCH * NG; bg += G) {
            const int g = bg & 31;
            const float ar = ((const float*)(ws + WS_SMALL + OFF_A64R))[g * 64 + lane], ai = ((const float*)(ws + WS_SMALL + OFF_A64I))[g * 64 + lane];
            float xr = 0.f, xi = 0.f; const size_t base = (size_t)bg * NCH * 128;
#pragma unroll 1
            for (int c0 = 0; c0 < NCH; c0 += 32) {
                float sr[32], si[32];
#pragma unroll
                for (int c = 0; c < 32; ++c) { sr[c] = SEND[base + (c0 + c) * 128 + lane]; si[c] = SEND[base + (c0 + c) * 128 + 64 + lane]; }
                asm volatile("" ::: "memory");
#pragma unroll
                for (int c = 0; c < 32; ++c) {
                    CARRY[base + (c0 + c) * 128 + lane] = xr; CARRY[base + (c0 + c) * 128 + 64 + lane] = xi;
                    const float nr = ar * xr - ai * xi + sr[c], ni = ar * xi + ai * xr + si[c]; xr = nr; xi = ni;
                }
            }
        }
    }
    xcd_barrier(xbar);

    if (PHMASK & 16) {
        LAS float* scr = (LAS float*)(lds + wid * SSM_WAVE_BYTES);
        for (int it = gw; it < BATCH * NG * NCH; it += NGW) { const int c = it & 63, g = (it >> 6) & 31, b = it >> 11; ssm_task<true>(b, g, c, ws, P.ssm_d, scr, lane); }
    }
    xcd_barrier(xbar);

    if (PHMASK & 32) {
        pg8::Gemm g{UB, Wt_glu, TOK, 512, 512}; pg8::StaticOrder S; S.init(TOK, 512, G, bx);
        EpiGlu E{UB, AOB, P.b_glu};
        pg8::gemm_phase<EpiGlu, pg8::StaticOrder>(lds, g, S, E);
    }
    xcd_barrier(xbar);

    if (PHMASK & 64) {
        pg8::Gemm g{AOB, Wt_pa, TOK, 1024, 1024}; pg8::StaticOrder S; S.init(TOK, 1024, G, bx);
        EpiMergeH E{(const unsigned char*)GB, MGB};
        pg8::gemm_phase<EpiMergeH, pg8::StaticOrder, true>(lds, g, S, E);
    }
    xcd_barrier(xbar);

    if (PHMASK & 128) {
        pg8::Gemm g{MGB, Wt_out, TOK, 1024, 1024}; pg8::StaticOrder S; S.init(TOK, 1024, G, bx);
        EpiOut E{XB, X1B, rss2};
        pg8::gemm_phase<EpiOut, pg8::StaticOrder>(lds, g, S, E);
    }
    xcd_barrier(xbar);

    for (int hf_ = 0; hf_ < 2; ++hf_) {
        const size_t r0 = (size_t)hf_ * (TOK / 2);
        if (PHMASK & 256) {
            pg8::Gemm g{X1B + r0 * 1024, Wt_mi, TOK / 2, FF, 1024}; pg8::StaticOrder S; S.init(TOK / 2, FF, G, bx);
            EpiMlpIn E{rss2 + r0, HB};
            pg8::gemm_phase<EpiMlpIn, pg8::StaticOrder>(lds, g, S, E);
        }
        xcd_barrier(xbar);
        if (PHMASK & 512) {
            pg8::Gemm g{HB, Wt_mo, TOK / 2, 1024, FF}; pg8::StaticOrder S; S.init(TOK / 2, 1024, G, bx);
            EpiMlpOut E{X1B + r0 * 1024, P.out + r0 * 1024};
            pg8::gemm_phase<EpiMlpOut, pg8::StaticOrder>(lds, g, S, E);
        }
        if (hf_ == 0) xcd_barrier(xbar);
    }
}

extern "C" void kernel_launch(void* const* d_in, const int* in_sizes, int n_in, void* d_out, int out_size, void* d_ws, size_t ws_size, hipStream_t stream) {
    static int grid = 0;
    if (grid == 0) {
        if (n_in != 27 || ws_size < WS_END) { fprintf(stderr, "kernel_launch: unexpected n_in %d or ws_size %zu\n", n_in, ws_size); grid = -1; return; }
        int dev = 0, cus = 0, per_cu = 0;
        hipGetDevice(&dev); hipDeviceGetAttribute(&cus, hipDeviceAttributeMultiprocessorCount, dev);
        if (hipFuncSetAttribute((const void*)mega, hipFuncAttributeMaxDynamicSharedMemorySize, LDS_BYTES) != hipSuccess) { fprintf(stderr, "kernel_launch: hipFuncSetAttribute failed\n"); }
        if (hipOccupancyMaxActiveBlocksPerMultiprocessor(&per_cu, (const void*)mega, 512, LDS_BYTES) != hipSuccess || per_cu < 1) { fprintf(stderr, "kernel_launch: occupancy query says %d\n", per_cu); per_cu = 1; }
        (void)hipGetLastError();
        grid = cus;
    }
    if (grid < 0) return;
    Params p{};
    const float** pp = (const float**)&p;
    for (int i = 0; i < 27; ++i) pp[i] = (const float*)d_in[i];
    p.out = (float*)d_out; p.ws = (unsigned char*)d_ws;
    if (hipMemsetAsync(d_ws, 0, 65536, stream) != hipSuccess) { fprintf(stderr, "kernel_launch: memset failed\n"); return; }
    void* args[] = {&p};
    hipError_t e = hipLaunchCooperativeKernel((const void*)mega, dim3(grid), dim3(512), args, LDS_BYTES, stream);
    if (e != hipSuccess) fprintf(stderr, "cooperative launch failed: %s (grid %d)\n", hipGetErrorString(e), grid);
}
```

```cpp
#include <hip/hip_runtime.h>
#include <hip/hip_cooperative_groups.h>
#include <cstdio>
#include <cstdint>
namespace cg = cooperative_groups;

#define LAS __attribute__((address_space(3)))
typedef unsigned short bf16_t;
typedef short bf16x8 __attribute__((ext_vector_type(8)));
typedef short s16x4 __attribute__((ext_vector_type(4)));
typedef float f32x4 __attribute__((ext_vector_type(4)));
typedef float f32x16 __attribute__((ext_vector_type(16)));
typedef unsigned u32x4 __attribute__((ext_vector_type(4)));
typedef unsigned u32x2 __attribute__((ext_vector_type(2)));
typedef float f32x2_t __attribute__((ext_vector_type(2)));
typedef __bf16 bf16x2_t __attribute__((ext_vector_type(2)));

__device__ __forceinline__ unsigned pk2(float lo, float hi) { f32x2_t v = {lo, hi}; bf16x2_t b = __builtin_convertvector(v, bf16x2_t); return __builtin_bit_cast(unsigned, b); }
__device__ __forceinline__ float bf_lo(unsigned w) { return __uint_as_float(w << 16); }
__device__ __forceinline__ float bf_hi(unsigned w) { return __uint_as_float(w & 0xffff0000u); }
__device__ __forceinline__ float fast_sigmoid(float x) { return __builtin_amdgcn_rcpf(1.0f + __builtin_amdgcn_exp2f(-1.4426950408889634f * x)); }
__device__ __forceinline__ float wave_sum(float v) {
#pragma unroll
    for (int o = 1; o < 64; o <<= 1) v += __shfl_xor(v, o);
    return v;
}
__device__ __forceinline__ float wave_max(float v) {
#pragma unroll
    for (int o = 1; o < 64; o <<= 1) v = fmaxf(v, __shfl_xor(v, o));
    return v;
}

constexpr int BATCH = 8, SEQ = 4096, DM = 1024, TOK = BATCH * SEQ, FF = 4096, INC = 4096;
constexpr int NG = 32, NP = 64, NCH = 64;
constexpr float EPS = 1e-6f;
constexpr float C2 = 0.125f * 1.4426950408889634f;

constexpr size_t MiB = 1u << 20;
constexpr size_t WS_SMALL = 1 * MiB;
constexpr size_t OFF_LBR = 0, OFF_LBI = 8192, OFF_A64R = 16384, OFF_A64I = 24576;
constexpr size_t OFF_BBF = 32768;
constexpr size_t OFF_CF = 32768 + 131072;
constexpr size_t OFF_RSTD1 = 32768 + 262144;
constexpr size_t OFF_RSS2 = OFF_RSTD1 + 131072;
constexpr size_t WS_W_IN = 2 * MiB, WS_W_MI = 10 * MiB, WS_W_MO = 18 * MiB, WS_W_OUT = 26 * MiB, WS_W_PA = 28 * MiB, WS_W_PS = 29 * MiB, WS_W_GLU = 30 * MiB;
constexpr size_t WS_SEND = 32 * MiB, WS_CARRY = 40 * MiB;
constexpr size_t WS_Q = 64 * MiB, WS_K = 96 * MiB, WS_V = 128 * MiB, WS_U = 160 * MiB, WS_G = 192 * MiB, WS_XB = 320 * MiB;
constexpr size_t WS_MG = 128 * MiB;
constexpr size_t WS_H = 128 * MiB;
constexpr size_t WS_X1B = WS_Q;
constexpr size_t WS_AO = 384 * MiB;
constexpr size_t WS_END = 448 * MiB;

#ifndef PHMASK
#define PHMASK 0xFFFF
#endif
constexpr int LDS_BYTES = 147456;
constexpr int RING_BYTES = 131072;

namespace pg8 {
constexpr int BM = 256, BK = 64, HALF = 128, HTB = HALF * BK * 2, NXCD = 8, WGM = 8;
__host__ __device__ __forceinline__ int lds_byte(int r, int c) { const int st = (r >> 4) * 2 + (c >> 5), rr = r & 15, cc = c & 31, ob = rr * 64 + cc * 2; return st * 1024 + (ob ^ (((ob >> 9) & 1) << 5)); }
__host__ __device__ __forceinline__ void stage_rc(int b, int& R, int& C) { const int st = b / 1024, sb = b % 1024, swz = sb ^ (((sb >> 9) & 1) << 5); R = (st >> 1) * 16 + swz / 64; C = (st & 1) * 32 + (swz % 64) / 2; }
__host__ __device__ __forceinline__ int perm32(int rho) { const int n = rho >> 4, i = rho & 15; return 8 * (i >> 2) + 4 * n + (i & 3); }
__device__ __forceinline__ void pg8_glds16(const void* sbase, unsigned voff, unsigned lds_dst) { unsigned keep;
    asm volatile("s_mov_b32 %0, m0\n\ts_mov_b32 m0, %3\n\ts_nop 0\n\tglobal_load_lds_dwordx4 %1, %2\n\ts_mov_b32 m0, %0" : "=&s"(keep) : "v"(voff), "s"(sbase), "s"(lds_dst) : "memory"); }
struct Unit { int pm, pn; };
struct Gemm { const bf16_t* A; const bf16_t* Bt; int M, N, K; };
struct StaticOrder {
    int nM, nN, nwg, G, c;
    __device__ void init(int M, int N, int G_, int c_) { nM = M / BM; nN = N / BM; nwg = nM * nN; G = G_; c = c_; }
    __device__ bool next(int i, Unit& u) const {
        const long L = (long)i * G + c; if (L >= nwg) return false;
        int wgid = (int)L; { const int q = nwg / NXCD, r = nwg % NXCD, xcd = wgid % NXCD, off = wgid / NXCD; wgid = (xcd < r ? xcd * (q + 1) : r * (q + 1) + (xcd - r) * q) + off; }
        const int nig = WGM * nN, gid = wgid / nig, fm = gid * WGM, gsz = (nM - fm) < WGM ? (nM - fm) : WGM;
        u.pm = fm + ((wgid % nig) % gsz); u.pn = (wgid % nig) / gsz; return true;
    }
};

template <class Epi, class Sched, bool MID = false>
__device__ __forceinline__ void gemm_phase(LAS unsigned char* lds, const Gemm g, const Sched& S, const Epi& E) {
    int tid = threadIdx.x; asm volatile("" : "+v"(tid));
    const int wid = __builtin_amdgcn_readfirstlane(tid >> 6), lane = tid & 63, wr = wid >> 2, wc = wid & 3, fr = lane & 15, fq = lane >> 4;
    const int K = g.K, nt = K / BK;
    unsigned voffA[2], voffB[2];
#pragma unroll
    for (int i = 0; i < 2; ++i) { int R, C; stage_rc(tid * 16 + i * 8192, R, C); const int Rb = (R & ~31) + perm32(R & 31);
        voffA[i] = (unsigned)(R * K + C) * 2u; voffB[i] = (unsigned)(Rb * K + C) * 2u; }
    const size_t kstep = (size_t)(BK * 2);
    const size_t hstep = (size_t)HALF * K * 2;
    const size_t tstep = 2 * hstep;
    const unsigned ldsw = (unsigned)wid * 1024u; const unsigned lds0_ = (unsigned)(uintptr_t)lds;
    const int aoff = lds_byte(wr * 64 + fr, fq * 8), boff = lds_byte(wc * 32 + fr, fq * 8);
#define PG8_SA(b, h) (((b) * 2 + (h)) * HTB)
#define PG8_SB(b, h) ((4 + (b) * 2 + (h)) * HTB)
#define PG8_STAGE(bufoff, gbase, voff) do { _Pragma("unroll") for (int _i = 0; _i < 2; ++_i) \
        pg8_glds16((const void*)(gbase), (voff)[_i], (unsigned)__builtin_amdgcn_readfirstlane(lds0_ + (bufoff) + ldsw + _i * 8192)); } while (0)
#define PG8_LDA(dst, b, h) do { _Pragma("unroll") for (int m = 0; m < 4; ++m) _Pragma("unroll") for (int k = 0; k < 2; ++k) dst[m][k] = *(const LAS bf16x8*)(lds + PG8_SA(b, h) + aoff + m * 2048 + k * 1024); } while (0)
#define PG8_LDB(dst, b, h) do { _Pragma("unroll") for (int n = 0; n < 2; ++n) _Pragma("unroll") for (int k = 0; k < 2; ++k) dst[n][k] = *(const LAS bf16x8*)(lds + PG8_SB(b, h) + boff + n * 2048 + k * 1024); } while (0)
#define PG8_MMA(ai, bj, At, Bt) do { __builtin_amdgcn_s_setprio(1); _Pragma("unroll") for (int m = 0; m < 4; ++m) _Pragma("unroll") for (int n = 0; n < 2; ++n) _Pragma("unroll") for (int k = 0; k < 2; ++k) \
        acc[ai][bj][m][n] = __builtin_amdgcn_mfma_f32_16x16x32_bf16(Bt[n][k], At[m][k], acc[ai][bj][m][n], 0, 0, 0); __builtin_amdgcn_s_setprio(0); } while (0)
#define PG8_WAIT_V(n) asm volatile("s_waitcnt vmcnt(" #n ")" ::: "memory")
#define PG8_WAIT_L(n) asm volatile("s_waitcnt lgkmcnt(" #n ")" ::: "memory")
#define PG8_BAR __builtin_amdgcn_s_barrier()
#define PG8_SCHED __builtin_amdgcn_sched_barrier(0)
    Unit cur, nxt; int ui = 0;
    if (!S.next(0, cur)) return;
    f32x4 acc[2][2][4][2];
#pragma unroll
    for (int a = 0; a < 2; ++a)
#pragma unroll
        for (int b = 0; b < 2; ++b)
#pragma unroll
            for (int m = 0; m < 4; ++m)
#pragma unroll
                for (int n = 0; n < 2; ++n) acc[a][b][m][n] = (f32x4){0.f, 0.f, 0.f, 0.f};
    bf16x8 At[4][2], B0[2][2], B1[2][2];
    const char* cA = (const char*)g.A + (size_t)cur.pm * tstep; const char* cB = (const char*)g.Bt + (size_t)cur.pn * tstep;
    PG8_STAGE(PG8_SB(0, 0), cB, voffB); PG8_STAGE(PG8_SB(0, 1), cB + hstep, voffB); PG8_STAGE(PG8_SA(0, 0), cA, voffA); PG8_STAGE(PG8_SA(0, 1), cA + hstep, voffA);
    if (wr == 1) PG8_BAR;
    PG8_WAIT_V(2); PG8_BAR;
    PG8_STAGE(PG8_SB(1, 0), cB + kstep, voffB); PG8_STAGE(PG8_SA(1, 0), cA + kstep, voffA); PG8_STAGE(PG8_SB(1, 1), cB + hstep + kstep, voffB);
    PG8_WAIT_V(6); PG8_BAR;
    for (;;) {
        const bool has_next = S.next(ui + 1, nxt);
        const char* nA = has_next ? (const char*)g.A + (size_t)nxt.pm * tstep : cA; const char* nB = has_next ? (const char*)g.Bt + (size_t)nxt.pn * tstep : cB;
        for (int t = 0; t < nt; t += 2) {
            const bool last = (t == nt - 2);
            const char* a1 = cA + (size_t)(t + 1) * kstep;
            const char* a2 = last ? nA : cA + (size_t)(t + 2) * kstep; const char* b2 = last ? nB : cB + (size_t)(t + 2) * kstep;
            const char* a3 = a2 + kstep; const char* b3 = b2 + kstep;
            if constexpr (MID) { if (t == nt / 2) E.mid(acc, cur, wr, wc, fr, fq); }
            PG8_LDB(B0, 0, 0); PG8_LDB(B1, 0, 1); PG8_SCHED; PG8_LDA(At, 0, 0); PG8_STAGE(PG8_SA(1, 1), a1 + hstep, voffA);
            PG8_WAIT_V(8); PG8_WAIT_L(0); PG8_BAR; PG8_MMA(0, 0, At, B0); PG8_MMA(0, 1, At, B1); PG8_BAR; PG8_SCHED;
            PG8_LDA(At, 0, 1); PG8_STAGE(PG8_SB(0, 0), b2, voffB); PG8_STAGE(PG8_SB(0, 1), b2 + hstep, voffB); PG8_STAGE(PG8_SA(0, 0), a2, voffA);
            PG8_WAIT_V(8); PG8_WAIT_L(0); PG8_BAR; PG8_MMA(1, 0, At, B0); PG8_MMA(1, 1, At, B1); PG8_BAR; PG8_SCHED;
            PG8_LDB(B0, 1, 0); PG8_LDB(B1, 1, 1); PG8_SCHED; PG8_LDA(At, 1, 0); PG8_STAGE(PG8_SA(0, 1), a2 + hstep, voffA);
            PG8_WAIT_V(8); PG8_WAIT_L(0); PG8_BAR; PG8_MMA(0, 0, At, B0); PG8_MMA(0, 1, At, B1); PG8_BAR; PG8_SCHED;
            PG8_LDA(At, 1, 1); PG8_STAGE(PG8_SB(1, 0), b3, voffB); PG8_STAGE(PG8_SB(1, 1), b3 + hstep, voffB); PG8_STAGE(PG8_SA(1, 0), a3, voffA);
            PG8_WAIT_V(8); PG8_WAIT_L(0); PG8_BAR; PG8_MMA(1, 0, At, B0); PG8_MMA(1, 1, At, B1); PG8_BAR; PG8_SCHED;
        }
        if (wr == 0) PG8_BAR;
        E(acc, cur, wr, wc, fr, fq);
        if (!has_next) break;
#pragma unroll
        for (int a = 0; a < 2; ++a)
#pragma unroll
            for (int b = 0; b < 2; ++b)
#pragma unroll
                for (int m = 0; m < 4; ++m)
#pragma unroll
                    for (int n = 0; n < 2; ++n) acc[a][b][m][n] = (f32x4){0.f, 0.f, 0.f, 0.f};
        cur = nxt; cA = nA; cB = nB; ++ui;
        if (wr == 1) PG8_BAR;
    }
    PG8_WAIT_V(0);
    PG8_BAR;
#undef PG8_SA
#undef PG8_SB
#undef PG8_STAGE
#undef PG8_LDA
#undef PG8_LDB
#undef PG8_MMA
#undef PG8_WAIT_V
#undef PG8_WAIT_L
#undef PG8_BAR
#undef PG8_SCHED
}
}

__device__ __forceinline__ int col_nat(int bj, int wc, int fq) { return 128 * bj + 32 * wc + 8 * fq; }
__device__ __forceinline__ int col_inp(int bj, int wc, int fq) { return 64 * wc + 16 * fq + 8 * bj; }

struct EpiIn {
    bf16_t *Q, *K, *V, *U, *G; const float *rstd, *qg, *kg, *bgate;
    __device__ __forceinline__ void operator()(const f32x4 (&acc)[2][2][4][2], const pg8::Unit& u, int wr, int wc, int fr, int fq) const {
        const int pn = u.pn; const int row0 = u.pm * 256 + wr * 64 + fr;
        if (pn < 4) {
            const bool isq = pn < 2; const float* g = isq ? qg : kg; bf16_t* dst = isq ? Q : K; const int colt = (pn & 1) * 256;
            const float post = isq ? C2 : 1.0f;
#pragma unroll
            for (int ai = 0; ai < 2; ++ai)
#pragma unroll
                for (int m = 0; m < 4; ++m) {
                    const int r = row0 + ai * 128 + m * 16; const float rs = rstd[r];
                    f32x4 v[2][2]; float ss = 0.f;
#pragma unroll
                    for (int bj = 0; bj < 2; ++bj)
#pragma unroll
                        for (int n = 0; n < 2; ++n) { v[bj][n] = acc[ai][bj][m][n] * rs; const f32x4 x = v[bj][n]; ss += (x[0] * x[0] + x[1] * x[1]) + (x[2] * x[2] + x[3] * x[3]); }
                    ss += __shfl_xor(ss, 16); ss += __shfl_xor(ss, 32);
                    const float sc = __builtin_amdgcn_rsqf(ss * (1.0f / 64.0f) + EPS) * post;
#pragma unroll
                    for (int bj = 0; bj < 2; ++bj) {
                        const f32x4 g0 = *(const f32x4*)(g + 16 * fq + 8 * bj), g1 = *(const f32x4*)(g + 16 * fq + 8 * bj + 4);
                        const f32x4 a = v[bj][0] * sc * g0, b = v[bj][1] * sc * g1;
                        u32x4 w; w.x = pk2(a[0], a[1]); w.y = pk2(a[2], a[3]); w.z = pk2(b[0], b[1]); w.w = pk2(b[2], b[3]);
                        *(u32x4*)(dst + (size_t)r * 512 + colt + col_inp(bj, wc, fq)) = w;
                    }
                }
        } else if (pn < 8) {
            bf16_t* dst = pn < 6 ? V : U; const int colt = (pn & 1) * 256;
#pragma unroll
            for (int ai = 0; ai < 2; ++ai)
#pragma unroll
                for (int m = 0; m < 4; ++m) {
                    const int r = row0 + ai * 128 + m * 16; const float rs = rstd[r];
#pragma unroll
                    for (int bj = 0; bj < 2; ++bj) {
                        const f32x4 a = acc[ai][bj][m][0] * rs, b = acc[ai][bj][m][1] * rs;
                        u32x4 w; w.x = pk2(a[0], a[1]); w.y = pk2(a[2], a[3]); w.z = pk2(b[0], b[1]); w.w = pk2(b[2], b[3]);
                        *(u32x4*)(dst + (size_t)r * 512 + colt + col_inp(bj, wc, fq)) = w;
                    }
                }
        } else {
            const int colt = (pn - 8) * 256;
            unsigned char* G8 = (unsigned char*)G;
#pragma unroll
            for (int ai = 0; ai < 2; ++ai)
#pragma unroll
                for (int m = 0; m < 4; ++m) {
                    const int r = row0 + ai * 128 + m * 16; const float rs = rstd[r];
                    u32x4 w;
#pragma unroll
                    for (int bj = 0; bj < 2; ++bj) {
                        const float* bp = bgate + colt + col_inp(bj, wc, fq);
                        const f32x4 a = acc[ai][bj][m][0] * rs + *(const f32x4*)bp, b = acc[ai][bj][m][1] * rs + *(const f32x4*)(bp + 4);
                        unsigned lo = 0u, hi = 0u;
#pragma unroll
                        for (int e = 0; e < 4; ++e) {
                            const unsigned qa = (unsigned)fminf(fmaxf(fast_sigmoid(a[e]) * 255.0f + 0.5f, 1.0f), 255.0f);
                            const unsigned qb = (unsigned)fminf(fmaxf(fast_sigmoid(b[e]) * 255.0f + 0.5f, 1.0f), 255.0f);
                            lo |= qa << (8 * e); hi |= qb << (8 * e);
                        }
                        if (bj == 0) { w.x = lo; w.y = hi; } else { w.z = lo; w.w = hi; }
                    }
                    __builtin_nontemporal_store(w, (u32x4*)(G8 + (size_t)r * 2048 + colt + col_inp(0, wc, fq)));
                }
        }
    }
};

struct EpiGlu {
    const bf16_t* Z; bf16_t* S; const float* bglu;
    __device__ __forceinline__ void operator()(const f32x4 (&acc)[2][2][4][2], const pg8::Unit& u, int wr, int wc, int fr, int fq) const {
        const int row0 = u.pm * 256 + wr * 64 + fr; const int colt = u.pn * 256;
#pragma unroll
        for (int bj = 0; bj < 2; ++bj) {
            const int c = colt + col_nat(bj, wc, fq);
            const f32x4 b0 = *(const f32x4*)(bglu + c), b1 = *(const f32x4*)(bglu + c + 4);
#pragma unroll
            for (int ai = 0; ai < 2; ++ai)
#pragma unroll
                for (int m = 0; m < 4; ++m) {
                    const int r = row0 + ai * 128 + m * 16;
                    const u32x4 z = *(const u32x4*)(Z + (size_t)r * 512 + c);
                    const f32x4 a = acc[ai][bj][m][0] + b0, b = acc[ai][bj][m][1] + b1;
                    u32x4 w;
                    w.x = pk2(bf_lo(z.x) * fast_sigmoid(a[0]), bf_hi(z.x) * fast_sigmoid(a[1]));
                    w.y = pk2(bf_lo(z.y) * fast_sigmoid(a[2]), bf_hi(z.y) * fast_sigmoid(a[3]));
                    w.z = pk2(bf_lo(z.z) * fast_sigmoid(b[0]), bf_hi(z.z) * fast_sigmoid(b[1]));
                    w.w = pk2(bf_lo(z.w) * fast_sigmoid(b[2]), bf_hi(z.w) * fast_sigmoid(b[3]));
                    *(u32x4*)(S + (size_t)r * 1024 + 512 + c) = w;
                }
        }
    }
};

struct EpiMergeH {
    const unsigned char* G; bf16_t* Mg;
    __device__ __forceinline__ void mid(f32x4 (&acc)[2][2][4][2], const pg8::Unit& u, int wr, int wc, int fr, int fq) const {
        asm volatile("" : "+v"(fr), "+v"(fq));
        const int row0 = u.pm * 256 + wr * 64 + fr; const int colt = u.pn * 256;
#pragma unroll
        for (int ai = 0; ai < 2; ++ai)
#pragma unroll
            for (int m = 0; m < 4; ++m) {
                const int r = row0 + ai * 128 + m * 16;
#pragma unroll
                for (int bj = 0; bj < 2; ++bj) {
                    const int c = colt + col_nat(bj, wc, fq);
                    const u32x2 ga = *(const u32x2*)(G + (size_t)r * 2048 + c), gs = *(const u32x2*)(G + (size_t)r * 2048 + 1024 + c);
                    f32x4 a = acc[ai][bj][m][0], b = acc[ai][bj][m][1];
#pragma unroll
                    for (int e = 0; e < 4; ++e) {
                        a[e] *= (float)((ga.x >> (8 * e)) & 0xffu) * __builtin_amdgcn_rcpf((float)((gs.x >> (8 * e)) & 0xffu));
                        b[e] *= (float)((ga.y >> (8 * e)) & 0xffu) * __builtin_amdgcn_rcpf((float)((gs.y >> (8 * e)) & 0xffu));
                    }
                    acc[ai][bj][m][0] = a; acc[ai][bj][m][1] = b;
                }
                if (m & 1) asm volatile("" ::: "memory");
            }
    }
    __device__ __forceinline__ void operator()(const f32x4 (&acc)[2][2][4][2], const pg8::Unit& u, int wr, int wc, int fr, int fq) const {
        const int row0 = u.pm * 256 + wr * 64 + fr; const int colt = u.pn * 256;
#pragma unroll
        for (int ai = 0; ai < 2; ++ai)
#pragma unroll
            for (int m = 0; m < 4; ++m) {
                const int r = row0 + ai * 128 + m * 16;
#pragma unroll
                for (int bj = 0; bj < 2; ++bj) {
                    const int c = colt + col_nat(bj, wc, fq);
                    const u32x2 gs = *(const u32x2*)(G + (size_t)r * 2048 + 1024 + c);
                    const f32x4 a = acc[ai][bj][m][0], b = acc[ai][bj][m][1];
                    float o[8];
#pragma unroll
                    for (int e = 0; e < 4; ++e) { o[e] = a[e] * ((float)((gs.x >> (8 * e)) & 0xffu) * (1.0f / 255.0f)); o[4 + e] = b[e] * ((float)((gs.y >> (8 * e)) & 0xffu) * (1.0f / 255.0f)); }
                    u32x4 w; w.x = pk2(o[0], o[1]); w.y = pk2(o[2], o[3]); w.z = pk2(o[4], o[5]); w.w = pk2(o[6], o[7]);
                    *(u32x4*)(Mg + (size_t)r * 1024 + c) = w;
                }
            }
    }
};

struct EpiOut {
    const bf16_t* X; bf16_t* X1B; float* rss;
    __device__ __forceinline__ void operator()(const f32x4 (&acc)[2][2][4][2], const pg8::Unit& u, int wr, int wc, int fr, int fq) const {
        const int row0 = u.pm * 256 + wr * 64 + fr; const int colt = u.pn * 256;
#pragma unroll
        for (int ai = 0; ai < 2; ++ai)
#pragma unroll
            for (int m = 0; m < 4; ++m) {
                const int r = row0 + ai * 128 + m * 16; float ss = 0.f;
#pragma unroll
                for (int bj = 0; bj < 2; ++bj) {
                    const int c = colt + col_nat(bj, wc, fq);
                    const u32x4 xv = *(const u32x4*)(X + (size_t)r * 1024 + c);
                    const f32x4 a0 = acc[ai][bj][m][0], a1 = acc[ai][bj][m][1];
                    f32x4 a, b;
                    a[0] = bf_lo(xv.x) + a0[0]; a[1] = bf_hi(xv.x) + a0[1]; a[2] = bf_lo(xv.y) + a0[2]; a[3] = bf_hi(xv.y) + a0[3];
                    b[0] = bf_lo(xv.z) + a1[0]; b[1] = bf_hi(xv.z) + a1[1]; b[2] = bf_lo(xv.w) + a1[2]; b[3] = bf_hi(xv.w) + a1[3];
                    ss += (a[0] * a[0] + a[1] * a[1]) + (a[2] * a[2] + a[3] * a[3]) + (b[0] * b[0] + b[1] * b[1]) + (b[2] * b[2] + b[3] * b[3]);
                    u32x4 w; w.x = pk2(a[0], a[1]); w.y = pk2(a[2], a[3]); w.z = pk2(b[0], b[1]); w.w = pk2(b[2], b[3]);
                    *(u32x4*)(X1B + (size_t)r * 1024 + c) = w;
                }
                ss += __shfl_xor(ss, 16); ss += __shfl_xor(ss, 32);
                if (fq == 0) atomicAdd(rss + r, ss);
            }
    }
};

struct EpiMlpIn {
    const float* rss; bf16_t* H;
    __device__ __forceinline__ void operator()(const f32x4 (&acc)[2][2][4][2], const pg8::Unit& u, int wr, int wc, int fr, int fq) const {
        const int row0 = u.pm * 256 + wr * 64 + fr; const int colt = u.pn * 256;
#pragma unroll
        for (int ai = 0; ai < 2; ++ai)
#pragma unroll
            for (int m = 0; m < 4; ++m) {
                const int r = row0 + ai * 128 + m * 16; const float rs = __builtin_amdgcn_rsqf(rss[r] * (1.0f / 1024.0f) + EPS);
#pragma unroll
                for (int bj = 0; bj < 2; ++bj) {
                    f32x4 a = acc[ai][bj][m][0] * rs, b = acc[ai][bj][m][1] * rs;
#pragma unroll
                    for (int e = 0; e < 4; ++e) { a[e] = fmaxf(a[e], 0.f); a[e] *= a[e]; b[e] = fmaxf(b[e], 0.f); b[e] *= b[e]; }
                    u32x4 w; w.x = pk2(a[0], a[1]); w.y = pk2(a[2], a[3]); w.z = pk2(b[0], b[1]); w.w = pk2(b[2], b[3]);
                    *(u32x4*)(H + (size_t)r * 4096 + colt + col_nat(bj, wc, fq)) = w;
                }
            }
    }
};

struct EpiMlpOut {
    const bf16_t* X1B; float* O;
    __device__ __forceinline__ void operator()(const f32x4 (&acc)[2][2][4][2], const pg8::Unit& u, int wr, int wc, int fr, int fq) const {
        const int row0 = u.pm * 256 + wr * 64 + fr; const int colt = u.pn * 256;
#pragma unroll
        for (int ai = 0; ai < 2; ++ai)
#pragma unroll
            for (int m = 0; m < 4; ++m) {
                const int r = row0 + ai * 128 + m * 16;
#pragma unroll
                for (int bj = 0; bj < 2; ++bj) {
                    const int c = colt + col_nat(bj, wc, fq);
                    const u32x4 xv = *(const u32x4*)(X1B + (size_t)r * 1024 + c);
                    const f32x4 a0 = acc[ai][bj][m][0], a1 = acc[ai][bj][m][1];
                    f32x4 a, b;
                    a[0] = bf_lo(xv.x) + a0[0]; a[1] = bf_hi(xv.x) + a0[1]; a[2] = bf_lo(xv.y) + a0[2]; a[3] = bf_hi(xv.y) + a0[3];
                    b[0] = bf_lo(xv.z) + a1[0]; b[1] = bf_hi(xv.z) + a1[1]; b[2] = bf_lo(xv.w) + a1[2]; b[3] = bf_hi(xv.w) + a1[3];
                    float* op = O + (size_t)r * 1024 + c;
                    __builtin_nontemporal_store(a, (f32x4*)op); __builtin_nontemporal_store(b, (f32x4*)(op + 4));
                }
            }
    }
};

namespace att {
constexpr int KOFF = 0, VOFF = 49152, TILEB = 16384;
__device__ __forceinline__ unsigned off_b(unsigned row, unsigned ch) { return 256u * row + 16u * (ch ^ (((row & 3u) << 2) | ((row >> 2) & 3u))); }
__device__ __forceinline__ int crow(int r, int hi) { return (r & 3) + 8 * (r >> 2) + 4 * hi; }
__device__ __forceinline__ s16x4 vtr(const LAS unsigned char* p) { return __builtin_bit_cast(s16x4, __builtin_amdgcn_ds_read_tr16_b64_v4i16((LAS s16x4*)p)); }

__device__ __forceinline__ void glds16(const void* gsrc, unsigned lds_dst) { unsigned keep;
    asm volatile("s_mov_b32 %0, m0\n\ts_mov_b32 m0, %2\n\ts_nop 0\n\tglobal_load_lds_dwordx4 %1, off\n\ts_mov_b32 m0, %0" : "=&s"(keep) : "v"(gsrc), "s"(lds_dst) : "memory"); }
__device__ __forceinline__ void scores_exp(const LAS unsigned char* Kb, const bf16x8 (&q)[4], const unsigned (&ka)[4], float negM, f32x16& sA, f32x16& sB) {
#pragma unroll
    for (int r = 0; r < 16; ++r) { sA[r] = 0.f; sB[r] = 0.f; }
#pragma unroll
    for (int s = 0; s < 4; ++s) {
        const bf16x8 kA = *(const LAS bf16x8*)(Kb + ka[s]);
        const bf16x8 kB = *(const LAS bf16x8*)(Kb + ka[s] + 8192);
        sA = __builtin_amdgcn_mfma_f32_32x32x16_bf16(kA, q[s], sA, 0, 0, 0);
        sB = __builtin_amdgcn_mfma_f32_32x32x16_bf16(kB, q[s], sB, 0, 0, 0);
    }
#pragma unroll
    for (int r = 0; r < 16; ++r) { sA[r] = __builtin_amdgcn_exp2f(sA[r]); sB[r] = __builtin_amdgcn_exp2f(sB[r]); }
}
__device__ __forceinline__ float sum16(const f32x16& a, const f32x16& b) {
    float s0 = a[0] + b[0], s1 = a[1] + b[1], s2 = a[2] + b[2], s3 = a[3] + b[3];
#pragma unroll
    for (int r = 4; r < 16; r += 4) { s0 += a[r] + b[r]; s1 += a[r + 1] + b[r + 1]; s2 += a[r + 2] + b[r + 2]; s3 += a[r + 3] + b[r + 3]; }
    return (s0 + s1) + (s2 + s3);
}

__device__ __forceinline__ void attn_unit(int b, int h, int qb, const bf16_t* Q, const bf16_t* K, const bf16_t* V, bf16_t* O, LAS unsigned char* lds,
                                          float lam, float negM, const float* subg) {
    int tid = threadIdx.x; asm volatile("" : "+v"(tid));
    const int lane = tid & 63, r32 = lane & 31, hi = lane >> 5; const int wid = __builtin_amdgcn_readfirstlane(tid >> 6);
    const size_t rowbase = (size_t)b * SEQ; const int q0 = qb * 256;
    const int ntiles = 4 * qb + 4, mytiles = 4 * qb + (wid >> 1) + 1;
    unsigned goff[2];
#pragma unroll
    for (int i = 0; i < 2; ++i) { const unsigned row = 8 * wid + 4 * i + (lane >> 4), cp = lane & 15, ch = cp ^ (((row & 3u) << 2) | ((row >> 2) & 3u));
        goff[i] = (row * 512 + h * 128 + ch * 8) * 2u; }
    const char* Kh = (const char*)(K + rowbase * 512); const char* Vh = (const char*)(V + rowbase * 512);
    const unsigned lds0 = (unsigned)(uintptr_t)lds;
#define ATT_DMA_K(t, slot) do { const size_t tb_ = (size_t)(t) * 64 * 512 * 2; _Pragma("unroll") for (int i_ = 0; i_ < 2; ++i_) \
        glds16(Kh + tb_ + goff[i_], (unsigned)__builtin_amdgcn_readfirstlane(lds0 + KOFF + (slot) * TILEB + (8 * wid + 4 * i_) * 256)); } while (0)
#define ATT_DMA_V(t, slot) do { const size_t tb_ = (size_t)(t) * 64 * 512 * 2; _Pragma("unroll") for (int i_ = 0; i_ < 2; ++i_) \
        glds16(Vh + tb_ + goff[i_], (unsigned)__builtin_amdgcn_readfirstlane(lds0 + VOFF + (slot) * TILEB + (8 * wid + 4 * i_) * 256)); } while (0)
    const bf16_t* Qw = Q + (rowbase + q0 + wid * 32 + r32) * 512 + h * 128;
    bf16x8 q1[4], q2[4];
#pragma unroll
    for (int s = 0; s < 4; ++s) { q1[s] = *(const bf16x8*)(Qw + 16 * s + 8 * hi); q2[s] = *(const bf16x8*)(Qw + 64 + 16 * s + 8 * hi); }
    unsigned ka1[4], ka2[4];
#pragma unroll
    for (int s = 0; s < 4; ++s) { ka1[s] = off_b(r32, 2 * s + hi); ka2[s] = off_b(r32, 8 + 2 * s + hi); }
    asm volatile("s_waitcnt vmcnt(0)" : "+v"(q1[0]), "+v"(q1[1]), "+v"(q1[2]), "+v"(q1[3]), "+v"(q2[0]), "+v"(q2[1]), "+v"(q2[2]), "+v"(q2[3]) :: "memory");
    float l1 = 0.f, l2 = 0.f;
    ATT_DMA_K(0, 0); ATT_DMA_K(1, 1);
    {
        int slot = 0, slot2 = 2;
        for (int t = 0; t < ntiles; ++t) {
            if (t + 1 < ntiles) asm volatile("s_waitcnt vmcnt(2)" ::: "memory"); else asm volatile("s_waitcnt vmcnt(0)" ::: "memory");
            __builtin_amdgcn_s_barrier();
            if (t + 2 < ntiles) ATT_DMA_K(t + 2, slot2);
            if (t < mytiles) {
                const LAS unsigned char* Kb = lds + KOFF + slot * TILEB;
                f32x16 sA, sB;
                scores_exp(Kb, q1, ka1, negM, sA, sB); l1 += sum16(sA, sB);
                scores_exp(Kb, q2, ka2, negM, sA, sB); l2 += sum16(sA, sB);
            }
            slot = (slot == 2) ? 0 : slot + 1; slot2 = (slot2 == 2) ? 0 : slot2 + 1;
        }
    }
    l1 += __shfl_xor(l1, 32); l2 += __shfl_xor(l2, 32);
    const float i1 = __builtin_amdgcn_rcpf(l1), i2 = lam * __builtin_amdgcn_rcpf(l2);
    asm volatile("s_waitcnt lgkmcnt(0)" ::: "memory");
    __builtin_amdgcn_s_barrier();
    f32x16 o[4];
#pragma unroll
    for (int c = 0; c < 4; ++c)
#pragma unroll
        for (int r = 0; r < 16; ++r) o[c][r] = 0.f;
    const unsigned blk = (lane >> 4) & 1, qq = (lane & 15) >> 2, pp = lane & 3;
    unsigned trb[2];
#pragma unroll
    for (int t = 0; t < 2; ++t) trb[t] = 256u * (8 * t + 4 * hi + qq) + 16u * ((2 * blk + (pp >> 1)) ^ (2 * t + hi)) + 8u * (pp & 1);
    ATT_DMA_K(0, 0); ATT_DMA_V(0, 0); ATT_DMA_K(1, 1); ATT_DMA_V(1, 1);
    {
        int slot = 0, slot2 = 2;
        for (int t = 0; t < ntiles; ++t) {
            if (t + 1 < ntiles) asm volatile("s_waitcnt vmcnt(4)" ::: "memory"); else asm volatile("s_waitcnt vmcnt(0)" ::: "memory");
            __builtin_amdgcn_s_barrier();
            if (t + 2 < ntiles) { ATT_DMA_K(t + 2, slot2); ATT_DMA_V(t + 2, slot2); }
            if (t < mytiles) {
                const LAS unsigned char* Kb = lds + KOFF + slot * TILEB; const LAS unsigned char* Vb = lds + VOFF + slot * TILEB;
                f32x16 pA, pB, rA, rB;
                scores_exp(Kb, q1, ka1, negM, pA, pB);
                scores_exp(Kb, q2, ka2, negM, rA, rB);
#pragma unroll
                for (int r = 0; r < 16; ++r) { pA[r] = pA[r] * i1 - rA[r] * i2; pB[r] = pB[r] * i1 - rB[r] * i2; }
                bf16x8 pa[4];
#pragma unroll
                for (int h2 = 0; h2 < 2; ++h2) {
                    u32x4 wa, wb;
                    wa.x = pk2(pA[8 * h2 + 0], pA[8 * h2 + 1]); wa.y = pk2(pA[8 * h2 + 2], pA[8 * h2 + 3]); wa.z = pk2(pA[8 * h2 + 4], pA[8 * h2 + 5]); wa.w = pk2(pA[8 * h2 + 6], pA[8 * h2 + 7]);
                    wb.x = pk2(pB[8 * h2 + 0], pB[8 * h2 + 1]); wb.y = pk2(pB[8 * h2 + 2], pB[8 * h2 + 3]); wb.z = pk2(pB[8 * h2 + 4], pB[8 * h2 + 5]); wb.w = pk2(pB[8 * h2 + 6], pB[8 * h2 + 7]);
                    pa[h2] = __builtin_bit_cast(bf16x8, wa); pa[2 + h2] = __builtin_bit_cast(bf16x8, wb);
                }
#pragma unroll
                for (int c = 0; c < 4; ++c) {
                    const unsigned cx = 64u * ((unsigned)c ^ qq);
#pragma unroll
                    for (int ks = 0; ks < 4; ++ks) {
                        const s16x4 lo = vtr(Vb + trb[0] + cx + ks * 4096), hi4 = vtr(Vb + trb[1] + cx + ks * 4096);
                        const bf16x8 vf = {lo[0], lo[1], lo[2], lo[3], hi4[0], hi4[1], hi4[2], hi4[3]};
                        o[c] = __builtin_amdgcn_mfma_f32_32x32x16_bf16(pa[ks], vf, o[c], 0, 0, 0);
                    }
                }
            }
            slot = (slot == 2) ? 0 : slot + 1; slot2 = (slot2 == 2) ? 0 : slot2 + 1;
        }
    }
#undef ATT_DMA_K
#undef ATT_DMA_V
    float sg[4];
#pragma unroll
    for (int c = 0; c < 4; ++c) sg[c] = subg[32 * c + r32] * 0.8f;
    bf16_t* Ow = O + (rowbase + q0 + wid * 32) * 1024 + h * 128 + r32;
#pragma unroll
    for (int r = 0; r < 16; ++r) {
        const int qr = crow(r, hi);
        float ss = 0.f;
#pragma unroll
        for (int c = 0; c < 4; ++c) ss += o[c][r] * o[c][r];
        ss += __shfl_xor(ss, 1); ss += __shfl_xor(ss, 2); ss += __shfl_xor(ss, 4); ss += __shfl_xor(ss, 8); ss += __shfl_xor(ss, 16);
        const float sc = __builtin_amdgcn_rsqf(ss * (1.0f / 128.0f) + EPS);
#pragma unroll
        for (int c = 0; c < 4; ++c) { const unsigned w = pk2(o[c][r] * sc * sg[c], 0.f); Ow[(size_t)qr * 1024 + 32 * c] = (bf16_t)(w & 0xffffu); }
    }
    asm volatile("s_waitcnt vmcnt(0) lgkmcnt(0)" ::: "memory");
    __builtin_amdgcn_s_barrier();
}
}

constexpr int SSM_XP = 68;
constexpr int SSM_LDP = 132;
constexpr int SSM_WAVE_BYTES = 17408;
template <bool FULL>
__device__ __forceinline__ void ssm_task(int b, int g, int c, unsigned char* ws, const float* Dvec, LAS float* scr, int lane) {
    const float* LBR = (const float*)(ws + WS_SMALL + OFF_LBR); const float* LBI = (const float*)(ws + WS_SMALL + OFF_LBI);
    const bf16x8* BBF = (const bf16x8*)(ws + WS_SMALL + OFF_BBF); const bf16x8* CF = (const bf16x8*)(ws + WS_SMALL + OFF_CF);
    bf16_t* U = (bf16_t*)(ws + WS_U);
    const int r32 = lane & 31, hi = lane >> 5;
    const float lbr = LBR[g * 64 + lane], lbi = LBI[g * 64 + lane];
    const size_t sidx = (((size_t)b * NG + g) * NCH + c) * 128;
    float xr = 0.f, xi = 0.f;
    if (FULL) { const float* CARRY = (const float*)(ws + WS_CARRY); xr = CARRY[sidx + lane]; xi = CARRY[sidx + 64 + lane]; }
    bf16x8 bfr[4];
#pragma unroll
    for (int cb = 0; cb < 4; ++cb) bfr[cb] = BBF[(g * 4 + cb) * 64 + lane];
    bf16x8 cfr[4];
    float dn = 0.f;
    if (FULL) {
#pragma unroll
        for (int s = 0; s < 4; ++s) cfr[s] = CF[(g * 4 + s) * 64 + lane];
        dn = Dvec[16 * g + (lane & 15)];
    }
    const size_t row0 = (size_t)b * SEQ + (size_t)c * 64;
#pragma unroll 1
    for (int jb = 0; jb < 2; ++jb) {
        const bf16x8 ua = *(const bf16x8*)(U + (row0 + 32 * jb + r32) * 512 + 16 * g + 8 * hi);
        bf16_t upre[2][4];
        if (FULL) {
#pragma unroll
            for (int jbb = 0; jbb < 2; ++jbb)
#pragma unroll
                for (int e = 0; e < 4; ++e) upre[jbb][e] = U[(row0 + 32 * jb + 16 * jbb + 4 * (lane >> 4) + e) * 512 + 16 * g + (lane & 15)];
        }
        f32x16 zr0, zr1, zi0, zi1;
#pragma unroll
        for (int r = 0; r < 16; ++r) { zr0[r] = 0.f; zr1[r] = 0.f; zi0[r] = 0.f; zi1[r] = 0.f; }
        zr0 = __builtin_amdgcn_mfma_f32_32x32x16_bf16(ua, bfr[0], zr0, 0, 0, 0);
        zr1 = __builtin_amdgcn_mfma_f32_32x32x16_bf16(ua, bfr[1], zr1, 0, 0, 0);
        zi0 = __builtin_amdgcn_mfma_f32_32x32x16_bf16(ua, bfr[2], zi0, 0, 0, 0);
        zi1 = __builtin_amdgcn_mfma_f32_32x32x16_bf16(ua, bfr[3], zi1, 0, 0, 0);
#pragma unroll
        for (int r = 0; r < 16; ++r) {
            const auto pr = __builtin_amdgcn_permlane32_swap(__float_as_uint(zr0[r]), __float_as_uint(zr1[r]), false, false);
            zr0[r] = __uint_as_float(pr[0]); zr1[r] = __uint_as_float(pr[1]);
            const auto pi = __builtin_amdgcn_permlane32_swap(__float_as_uint(zi0[r]), __float_as_uint(zi1[r]), false, false);
            zi0[r] = __uint_as_float(pi[0]); zi1[r] = __uint_as_float(pi[1]);
        }
#pragma unroll
        for (int j = 0; j < 32; ++j) {
            const int hh = (j >> 2) & 1, rr = (j & 3) + 4 * (j >> 3);
            const float br = hh ? zr1[rr] : zr0[rr], bi = hh ? zi1[rr] : zi0[rr];
            const float nr = lbr * xr - lbi * xi + br, ni = lbr * xi + lbi * xr + bi;
            xr = nr; xi = ni;
            if (FULL) ((LAS unsigned*)scr)[j * SSM_XP + lane] = pk2(xr, xi);
        }
        if (FULL) {
            asm volatile("s_waitcnt lgkmcnt(0)" ::: "memory");
            __builtin_amdgcn_wave_barrier();
            const int n = lane & 15, kq = lane >> 4;
            float zv[2][4];
#pragma unroll
            for (int jbb = 0; jbb < 2; ++jbb) {
                f32x4 y = {0.f, 0.f, 0.f, 0.f};
#pragma unroll
                for (int s = 0; s < 4; ++s) {
                    const bf16x8 xa = *(const LAS bf16x8*)((const LAS unsigned*)scr + (16 * jbb + n) * SSM_XP + 16 * s + 4 * kq);
                    y = __builtin_amdgcn_mfma_f32_16x16x32_bf16(xa, cfr[s], y, 0, 0, 0);
                }
#pragma unroll
                for (int e = 0; e < 4; ++e) {
                    const float uu = __uint_as_float(((unsigned)upre[jbb][e]) << 16);
                    const float yv = y[e] + dn * uu;
                    const float inner = 0.7978845608028654f * (yv + 0.044715f * yv * yv * yv);
                    zv[jbb][e] = yv * fast_sigmoid(2.0f * inner);
                }
            }
            asm volatile("s_waitcnt lgkmcnt(0)" ::: "memory"); __builtin_amdgcn_wave_barrier();
            {
                LAS unsigned char* sb = (LAS unsigned char*)scr;
#pragma unroll
                for (int jbb = 0; jbb < 2; ++jbb)
#pragma unroll
                    for (int e = 0; e < 4; ++e) *(LAS bf16_t*)(sb + (16 * jbb + 4 * kq + e) * 32 + n * 2) = (bf16_t)(pk2(zv[jbb][e], 0.f) & 0xffffu);
                asm volatile("s_waitcnt lgkmcnt(0)" ::: "memory"); __builtin_amdgcn_wave_barrier();
                const u32x4 zz = *(const LAS u32x4*)(sb + (lane >> 1) * 32 + (lane & 1) * 16);
                *(u32x4*)(U + (row0 + 32 * jb + (lane >> 1)) * 512 + 16 * g + 8 * (lane & 1)) = zz;
            }
            asm volatile("s_waitcnt lgkmcnt(0)" ::: "memory");
            __builtin_amdgcn_wave_barrier();
        }
    }
    if (!FULL) { float* SEND = (float*)(ws + WS_SEND); SEND[sidx + lane] = xr; SEND[sidx + 64 + lane] = xi; }
}

template <bool HASG>
__device__ __forceinline__ void p0_transpose_item(const float* W, int K, int N, bf16_t* WT, bool permw, const float* gk, LAS float* scr, int item, int lane, int ldk = 0, int koff = 0) {
    if (ldk == 0) ldk = K;
    const int nblk = N / 32, kb = item / nblk, nb = item % nblk, k0 = 64 * kb, n0 = 32 * nb;
    f32x4 v[8]; float gv[8];
    const int lr = lane >> 3, lc = (lane & 7) * 4;
    const float* wp = W + (size_t)(k0 + lr) * N + n0 + lc;
#pragma unroll
    for (int i = 0; i < 8; ++i) { v[i] = __builtin_nontemporal_load((const f32x4*)(wp + (size_t)(8 * i) * N)); if (HASG) gv[i] = gk[k0 + lr + 8 * i]; }
    asm volatile("" ::: "memory");
#pragma unroll
    for (int i = 0; i < 8; ++i) { const int kk = lr + 8 * i; const f32x4 x = HASG ? v[i] * gv[i] : v[i];
        scr[kk * 33 + lc + 0] = x[0]; scr[kk * 33 + lc + 1] = x[1]; scr[kk * 33 + lc + 2] = x[2]; scr[kk * 33 + lc + 3] = x[3]; }
    asm volatile("s_waitcnt lgkmcnt(0)" ::: "memory"); __builtin_amdgcn_wave_barrier();
    int p0 = n0;
    const int c = lane & 7;
#pragma unroll
    for (int j = 0; j < 4; ++j) { const int n = (lane >> 3) + 8 * j; const LAS float* s = scr + (8 * c) * 33 + n;
        u32x4 o; o.x = pk2(s[0 * 33], s[1 * 33]); o.y = pk2(s[2 * 33], s[3 * 33]); o.z = pk2(s[4 * 33], s[5 * 33]); o.w = pk2(s[6 * 33], s[7 * 33]);
        int prow = p0 + n;
        if (permw) { const int lam_ = n0 + n, pn = lam_ >> 8, w = (lam_ >> 6) & 3, f = (lam_ >> 4) & 3, bb = (lam_ >> 3) & 1, jj = lam_ & 7; prow = pn * 256 + bb * 128 + w * 32 + f * 8 + jj; }
        *(u32x4*)(WT + (size_t)prow * ldk + koff + k0 + 8 * c) = o; }
    asm volatile("s_waitcnt lgkmcnt(0)" ::: "memory"); __builtin_amdgcn_wave_barrier();
}

__device__ __forceinline__ void sincos_d(double x, double& s, double& c) {
    const double TWO_PI = 6.283185307179586476925;
    const double k = __builtin_rint(x / TWO_PI); const double r = x - k * TWO_PI; const double r2 = r * r;
    double ts = 1.0, tc = 1.0;
#pragma unroll 1
    for (int n = 16; n >= 1; --n) { ts = 1.0 - ts * r2 / (double)((2 * n) * (2 * n + 1)); tc = 1.0 - tc * r2 / (double)((2 * n - 1) * (2 * n)); }
    s = r * ts; c = tc;
}

#define RLX_AGENT __ATOMIC_RELAXED, __HIP_MEMORY_SCOPE_AGENT
#define XB_TMO      128
#define XB_XCNT(j)  (256  + 64 * (j))
#define XB_XSUB(j)  (1280 + 64 * (j))
#define XB_XGEN(j)  (2304 + 64 * (j))
#define XB_TOP      3328
#define XB_TOPGEN   3392
#define XCD_BAR_WORDS 3456
#define XB_SPIN_CAP (1u << 20)
__device__ __forceinline__ unsigned xb_ld(unsigned* p)              { return __hip_atomic_load(p, __ATOMIC_RELAXED, __HIP_MEMORY_SCOPE_AGENT); }
__device__ __forceinline__ unsigned xb_add(unsigned* p, unsigned v) { return __hip_atomic_fetch_add(p, v, __ATOMIC_RELAXED, __HIP_MEMORY_SCOPE_AGENT); }
__device__ __forceinline__ unsigned xb_xcc_id() { return (unsigned)__builtin_amdgcn_s_getreg((3 << 11) | 20) & 0xFu; }
#define XB_SPIN(cond, bar) do { unsigned _sp = 0; while (cond) { __builtin_amdgcn_s_sleep(1); \
    if ((++_sp & 255u) == 0u) { if (xb_ld(&(bar)[XB_TMO])) break; if (_sp > XB_SPIN_CAP) { atomicAdd(&(bar)[XB_TMO], 1u); break; } } } } while (0)
struct XcdBarrier { unsigned* bar; unsigned x; volatile LAS unsigned* st; };
__device__ __forceinline__ XcdBarrier xcd_barrier_post(unsigned* bar, volatile LAS unsigned* st) {
    XcdBarrier b; b.bar = bar; b.x = xb_xcc_id(); b.st = st;
    if (threadIdx.x == 0) (void)xb_add(&bar[XB_XCNT(b.x)], 1u);
    return b;
}
__device__ __forceinline__ void xcd_barrier_complete(unsigned* bar, unsigned x, unsigned& nloc, unsigned& nx) {
    const unsigned G = gridDim.x * gridDim.y * gridDim.z;
    unsigned sum, cnt, mine, sp = 0u;
    for (;;) {
        sum = 0u; cnt = 0u; mine = 0u;
#pragma unroll
        for (unsigned j = 0; j < 16; ++j) { const unsigned c = xb_ld(&bar[XB_XCNT(j)]); sum += c; cnt += (c > 0u) ? 1u : 0u; mine = (j == x) ? c : mine; }
        if (sum == G) break;
        __builtin_amdgcn_s_sleep(1);
        if ((++sp & 255u) == 0u) { if (xb_ld(&bar[XB_TMO])) break; if (sp > XB_SPIN_CAP) { atomicAdd(&bar[XB_TMO], 1u); break; } }
    }
    nloc = mine > 0u ? mine : 1u; nx = cnt > 0u ? cnt : 1u;
}
__device__ __forceinline__ void xcd_barrier(const XcdBarrier& b) {
    asm volatile("s_waitcnt vmcnt(0)" ::: "memory");
    __syncthreads();
    if (threadIdx.x == 0) {
        unsigned* bar = b.bar;
        __builtin_amdgcn_s_waitcnt(0);
        unsigned nloc = b.st[0], nx = b.st[1];
        if (nloc == 0u) { xcd_barrier_complete(bar, b.x, nloc, nx); b.st[0] = nloc; b.st[1] = nx; }
        const unsigned old = xb_add(&bar[XB_XSUB(b.x)], 1u);
        const unsigned gen = old / nloc;
        if (old + 1u == (gen + 1u) * nloc) {
            __builtin_amdgcn_fence(__ATOMIC_RELEASE, "agent");
            asm volatile("s_waitcnt vmcnt(0)" ::: "memory");
            const unsigned og = xb_add(&bar[XB_TOP], 1u);
            const unsigned tg = og / nx;
            if (og + 1u == (tg + 1u) * nx) xb_add(&bar[XB_TOPGEN], 1u);
            else XB_SPIN(xb_ld(&bar[XB_TOPGEN]) == tg, bar);
            __builtin_amdgcn_fence(__ATOMIC_ACQUIRE, "agent");
            xb_add(&bar[XB_XGEN(b.x)], 1u);
            asm volatile("s_waitcnt vmcnt(0)" ::: "memory");
        } else {
            XB_SPIN(xb_ld(&bar[XB_XGEN(b.x)]) == gen, bar);
            __builtin_amdgcn_fence(__ATOMIC_ACQUIRE, "agent");
            asm volatile("s_waitcnt vmcnt(0)" ::: "memory");
        }
    }
    __syncthreads();
}

struct Params {
    const float *x, *norm_mix_g, *w_in, *b_gate, *q_norm_g, *k_norm_g, *lq1, *lk1, *lq2, *lk2, *subln_g, *a_re, *a_im, *log_dt, *b_re, *b_im, *c_re, *c_im, *ssm_d,
        *w_glu, *b_glu, *w_pa, *w_ps, *w_out, *norm_mlp_g, *w_mi, *w_mo;
    float* out; unsigned char* ws;
};

__global__ void __launch_bounds__(512, 2) mega(Params P) {
    extern __shared__ __attribute__((aligned(16))) unsigned char lds_raw[];
    LAS unsigned char* lds = (LAS unsigned char*)lds_raw;
    cg::grid_group grid = cg::this_grid();
    const int tid = threadIdx.x, lane = tid & 63; const int wid = __builtin_amdgcn_readfirstlane(tid >> 6);
    const int G = gridDim.x, bx = blockIdx.x;
    const int vcu = (G % 8 == 0) ? (bx % 8) * (G / 8) + bx / 8 : bx;
    const int gw = vcu * 8 + wid, NGW = G * 8;
    unsigned char* ws = P.ws;
    volatile LAS unsigned* xst = (volatile LAS unsigned*)(lds + LDS_BYTES - 64);
    if (tid < 16) xst[tid] = 0u;
    __syncthreads();
    XcdBarrier xbar = xcd_barrier_post((unsigned*)ws, xst);
#define Wt_in ((bf16_t*)(ws + WS_W_IN))
#define Wt_mi ((bf16_t*)(ws + WS_W_MI))
#define Wt_mo ((bf16_t*)(ws + WS_W_MO))
#define Wt_out ((bf16_t*)(ws + WS_W_OUT))
#define Wt_pa ((bf16_t*)(ws + WS_W_PA))
#define Wt_ps ((bf16_t*)(ws + WS_W_PS))
#define Wt_glu ((bf16_t*)(ws + WS_W_GLU))
#define QB ((bf16_t*)(ws + WS_Q))
#define KB ((bf16_t*)(ws + WS_K))
#define VB ((bf16_t*)(ws + WS_V))
#define UB ((bf16_t*)(ws + WS_U))
#define GB ((bf16_t*)(ws + WS_G))
#define XB ((bf16_t*)(ws + WS_XB))
#define HB ((bf16_t*)(ws + WS_H))
#define X1B ((bf16_t*)(ws + WS_X1B))
#define AOB ((bf16_t*)(ws + WS_AO))
#define MGB ((bf16_t*)(ws + WS_MG))
#define rstd1 ((float*)(ws + WS_SMALL + OFF_RSTD1))
#define rss2 ((float*)(ws + WS_SMALL + OFF_RSS2))

    {
        LAS float* scr = (LAS float*)(lds + wid * 16384);
        for (int gt = bx * 512 + tid; gt < NG * NP * 16; gt += G * 512) {
            const int gp = gt >> 4, n = gt & 15, g = gp >> 6, p = gp & 63;
            const double dt = exp((double)P.log_dt[g]); const double ar = (double)P.a_re[gp], ai = (double)P.a_im[gp];
            const double mag = exp(ar * dt); double sn, cs; sincos_d(ai * dt, sn, cs);
            const double lr = mag * cs, li = mag * sn; const double den = ar * ar + ai * ai; const double nr = lr - 1.0, ni = li;
            const double fr = (nr * ar + ni * ai) / den, fi = (ni * ar - nr * ai) / den;
            if (n == 0) {
                double pr = lr, pi = li;
#pragma unroll 1
                for (int k = 0; k < 6; ++k) { const double t = pr * pr - pi * pi; pi = 2.0 * pr * pi; pr = t; }
                ((float*)(ws + WS_SMALL + OFF_LBR))[gp] = (float)lr; ((float*)(ws + WS_SMALL + OFF_LBI))[gp] = (float)li;
                ((float*)(ws + WS_SMALL + OFF_A64R))[gp] = (float)pr; ((float*)(ws + WS_SMALL + OFF_A64I))[gp] = (float)pi;
            }
            bf16_t* BBF = (bf16_t*)(ws + WS_SMALL + OFF_BBF);
            const double br = (double)P.b_re[gt], bi = (double)P.b_im[gt];
            const float vre = (float)(fr * br - fi * bi), vim = (float)(fr * bi + fi * br);
            const int hi = n >> 3, e = n & 7, ln = (p & 31) + 32 * hi;
            BBF[(((size_t)g * 4 + (p >> 5)) * 64 + ln) * 8 + e] = (bf16_t)(pk2(vre, 0.f) & 0xffffu);
            BBF[(((size_t)g * 4 + 2 + (p >> 5)) * 64 + ln) * 8 + e] = (bf16_t)(pk2(vim, 0.f) & 0xffffu);
        }
        for (int gt = bx * 512 + tid; gt < NG * 4 * 64 * 8; gt += G * 512) {
            const int e = gt & 7, q = gt >> 3, g = q >> 8, s = (q >> 6) & 3, ln = q & 63, n = ln & 15, kq = ln >> 4;
            bf16_t* CF = (bf16_t*)(ws + WS_SMALL + OFF_CF);
            const int col = 32 * s + 8 * kq + e, pst = col >> 1;
            const float v = (col & 1) ? -P.c_im[((size_t)g * 16 + n) * 64 + pst] : P.c_re[((size_t)g * 16 + n) * 64 + pst];
            CF[gt] = (bf16_t)(pk2(v, 0.f) & 0xffffu);
        }
        constexpr int I_IN = 16 * 128, I_GLU = 8 * 16, I_PA = 8 * 32, I_PS = 8 * 32, I_OUT = 16 * 32, I_MI = 16 * 128, I_MO = 64 * 32;
        constexpr int NITEMS = I_IN + I_GLU + I_PA + I_PS + I_OUT + I_MI + I_MO;
        constexpr int NQUAD = TOK / 4;
        for (int it = gw; it < NITEMS + NQUAD; it += NGW) {
            int r = it;
            if (r < I_IN) { p0_transpose_item<true>(P.w_in, 1024, 4096, Wt_in, true, P.norm_mix_g, scr, r, lane); continue; } r -= I_IN;
            if (r < I_GLU) { p0_transpose_item<false>(P.w_glu, 512, 512, Wt_glu, false, nullptr, scr, r, lane); continue; } r -= I_GLU;
            if (r < I_PA) { p0_transpose_item<false>(P.w_pa, 512, 1024, Wt_pa, false, nullptr, scr, r, lane, 1024, 0); continue; } r -= I_PA;
            if (r < I_PS) { p0_transpose_item<false>(P.w_ps, 512, 1024, Wt_pa, false, nullptr, scr, r, lane, 1024, 512); continue; } r -= I_PS;
            if (r < I_OUT) { p0_transpose_item<false>(P.w_out, 1024, 1024, Wt_out, false, nullptr, scr, r, lane); continue; } r -= I_OUT;
            if (r < I_MI) { p0_transpose_item<true>(P.w_mi, 1024, 4096, Wt_mi, false, P.norm_mlp_g, scr, r, lane); continue; } r -= I_MI;
            if (r < I_MO) { p0_transpose_item<false>(P.w_mo, 4096, 1024, Wt_mo, false, nullptr, scr, r, lane); continue; } r -= I_MO;
            const int m0 = 4 * r;
            f32x4 v[4][4];
#pragma unroll
            for (int q = 0; q < 4; ++q) { const f32x4* xr = (const f32x4*)(P.x + (size_t)(m0 + q) * DM) + lane;
#pragma unroll
                for (int j = 0; j < 4; ++j) v[q][j] = __builtin_nontemporal_load(xr + 64 * j); }
            asm volatile("" ::: "memory");
#pragma unroll
            for (int q = 0; q < 4; ++q) {
                float s = 0.f;
#pragma unroll
                for (int j = 0; j < 4; ++j) s += (v[q][j][0] * v[q][j][0] + v[q][j][1] * v[q][j][1]) + (v[q][j][2] * v[q][j][2] + v[q][j][3] * v[q][j][3]);
                s = wave_sum(s);
                u32x2* o8 = (u32x2*)(XB + (size_t)(m0 + q) * DM) + lane;
#pragma unroll
                for (int j = 0; j < 4; ++j) { u32x2 w; w.x = pk2(v[q][j][0], v[q][j][1]); w.y = pk2(v[q][j][2], v[q][j][3]); o8[64 * j] = w; }
                if (lane == 0) { rstd1[m0 + q] = 1.0f / sqrtf(s * (1.0f / 1024.0f) + EPS); rss2[m0 + q] = 0.f; }
            }
        }
    }
    if (__builtin_expect(P.out == nullptr, 0)) grid.sync();
    xcd_barrier(xbar);

    if (PHMASK & 2) {
        pg8::Gemm g{XB, Wt_in, TOK, INC, DM}; pg8::StaticOrder S; S.init(TOK, INC, G, bx);
        EpiIn E{QB, KB, VB, UB, GB, rstd1, P.q_norm_g, P.k_norm_g, P.b_gate};
        pg8::gemm_phase<EpiIn, pg8::StaticOrder>(lds, g, S, E);
    }
    xcd_barrier(xbar);

    if (PHMASK & 4) {
        LAS float* scr = (LAS float*)(lds + wid * SSM_WAVE_BYTES);
        for (int it = gw; it < BATCH * NG * NCH; it += NGW) { const int c = it & 63, g = (it >> 6) & 31, b = it >> 11; ssm_task<false>(b, g, c, ws, P.ssm_d, scr, lane); }
        __syncthreads();
        const float d1 = wave_sum(P.lq1[lane] * P.lk1[lane]), d2 = wave_sum(P.lq2[lane] * P.lk2[lane]);
        const float lam = __builtin_amdgcn_exp2f(d1 * 1.4426950408889634f) - __builtin_amdgcn_exp2f(d2 * 1.4426950408889634f) + 0.2f;
        const float gqm = wave_max(fabsf(P.q_norm_g[lane])), gkm = wave_max(fabsf(P.k_norm_g[lane]));
        const float negM = 0.0f; (void)gqm; (void)gkm;
        for (int i = 0;; ++i) {
            const int idx = vcu + i * G; if (idx >= 512) break;
            const int pr = idx & 255, second = idx >> 8, bh = pr >> 3, s = pr & 7, qb = second ? 15 - s : s;
            att::attn_unit(bh >> 2, bh & 3, qb, QB, KB, VB, AOB, lds, lam, negM, P.subln_g);
        }
    }
    xcd_barrier(xbar);

    if ((PHMASK & 8) && wid == 0) {
        const float* SEND = (const float*)(ws + WS_SEND); float* CARRY = (float*)(ws + WS_CARRY);
        for (int bg = bx; bg < BATCH * NG; bg += G) {
            const int g = bg & 31;
            const float ar = ((const float*)(ws + WS_SMALL + OFF_A64R))[g * 64 + lane], ai = ((const float*)(ws + WS_SMALL + OFF_A64I))[g * 64 + lane];
            float xr = 0.f, xi = 0.f; const size_t base = (size_t)bg * NCH * 128;
#pragma unroll 1
            for (int c0 = 0; c0 < NCH; c0 += 32) {
                float sr[32], si[32];
#pragma unroll
                for (int c = 0; c < 32; ++c) { sr[c] = SEND[base + (c0 + c) * 128 + lane]; si[c] = SEND[base + (c0 + c) * 128 + 64 + lane]; }
                asm volatile("" ::: "memory");
#pragma unroll
                for (int c = 0; c < 32; ++c) {
                    CARRY[base + (c0 + c) * 128 + lane] = xr; CARRY[base + (c0 + c) * 128 + 64 + lane] = xi;
                    const float nr = ar * xr - ai * xi + sr[c], ni = ar * xi + ai * xr + si[c]; xr = nr; xi = ni;
                }
            }
        }
    }
    xcd_barrier(xbar);

    if (PHMASK & 16) {
        LAS float* scr = (LAS float*)(lds + wid * SSM_WAVE_BYTES);
        for (int it = gw; it < BATCH * NG * NCH; it += NGW) { const int c = it & 63, g = (it >> 6) & 31, b = it >> 11; ssm_task<true>(b, g, c, ws, P.ssm_d, scr, lane); }
    }
    xcd_barrier(xbar);

    if (PHMASK & 32) {
        pg8::Gemm g{UB, Wt_glu, TOK, 512, 512}; pg8::StaticOrder S; S.init(TOK, 512, G, bx);
        EpiGlu E{UB, AOB, P.b_glu};
        pg8::gemm_phase<EpiGlu, pg8::StaticOrder>(lds, g, S, E);
    }
    xcd_barrier(xbar);

    if (PHMASK & 64) {
        pg8::Gemm g{AOB, Wt_pa, TOK, 1024, 1024}; pg8::StaticOrder S; S.init(TOK, 1024, G, bx);
        EpiMergeH E{(const unsigned char*)GB, MGB};
        pg8::gemm_phase<EpiMergeH, pg8::StaticOrder, true>(lds, g, S, E);
    }
    xcd_barrier(xbar);

    if (PHMASK & 128) {
        pg8::Gemm g{MGB, Wt_out, TOK, 1024, 1024}; pg8::StaticOrder S; S.init(TOK, 1024, G, bx);
        EpiOut E{XB, X1B, rss2};
        pg8::gemm_phase<EpiOut, pg8::StaticOrder>(lds, g, S, E);
    }
    xcd_barrier(xbar);

    for (int hf_ = 0; hf_ < 2; ++hf_) {
        const size_t r0 = (size_t)hf_ * (TOK / 2);
        if (PHMASK & 256) {
            pg8::Gemm g{X1B + r0 * 1024, Wt_mi, TOK / 2, FF, 1024}; pg8::StaticOrder S; S.init(TOK / 2, FF, G, bx);
            EpiMlpIn E{rss2 + r0, HB};
            pg8::gemm_phase<EpiMlpIn, pg8::StaticOrder>(lds, g, S, E);
        }
        xcd_barrier(xbar);
        if (PHMASK & 512) {
            pg8::Gemm g{HB, Wt_mo, TOK / 2, 1024, FF}; pg8::StaticOrder S; S.init(TOK / 2, 1024, G, bx);
            EpiMlpOut E{X1B + r0 * 1024, P.out + r0 * 1024};
            pg8::gemm_phase<EpiMlpOut, pg8::StaticOrder>(lds, g, S, E);
        }
        if (hf_ == 0) xcd_barrier(xbar);
    }
}

extern "C" void kernel_launch(void* const* d_in, const int* in_sizes, int n_in, void* d_out, int out_size, void* d_ws, size_t ws_size, hipStream_t stream) {
    static int grid = 0;
    if (grid == 0) {
        if (n_in != 27 || ws_size < WS_END) { fprintf(stderr, "kernel_launch: unexpected n_in %d or ws_size %zu\n", n_in, ws_size); grid = -1; return; }
        int dev = 0, cus = 0, per_cu = 0;
        hipGetDevice(&dev); hipDeviceGetAttribute(&cus, hipDeviceAttributeMultiprocessorCount, dev);
        if (hipFuncSetAttribute((const void*)mega, hipFuncAttributeMaxDynamicSharedMemorySize, LDS_BYTES) != hipSuccess) { fprintf(stderr, "kernel_launch: hipFuncSetAttribute failed\n"); }
        if (hipOccupancyMaxActiveBlocksPerMultiprocessor(&per_cu, (const void*)mega, 512, LDS_BYTES) != hipSuccess || per_cu < 1) { fprintf(stderr, "kernel_launch: occupancy query says %d\n", per_cu); per_cu = 1; }
        (void)hipGetLastError();
        grid = cus;
    }
    if (grid < 0) return;
    Params p{};
    const float** pp = (const float**)&p;
    for (int i = 0; i < 27; ++i) pp[i] = (const float*)d_in[i];
    p.out = (float*)d_out; p.ws = (unsigned char*)d_ws;
    if (hipMemsetAsync(d_ws, 0, 65536, stream) != hipSuccess) { fprintf(stderr, "kernel_launch: memset failed\n"); return; }
    void* args[] = {&p};
    hipError_t e = hipLaunchCooperativeKernel((const void*)mega, dim3(grid), dim3(512), args, LDS_BYTES, stream);
    if (e != hipSuccess) fprintf(stderr, "cooperative launch failed: %s (grid %d)\n", hipGetErrorString(e), grid);
}
```
